# Optimizing an MI355X kernel written in HIP

```python
import math
import jax, jax.numpy as jnp
from jax import lax
import numpy as np

D_MODEL = 2048
BATCH = 4
SEQ = 2048
DEPTH = 2
DEC_BATCH = 128
DEC_SEQ = 1
PAST_LEN = 16384
PAGE_SIZE = 128

GROUP_WIDTH = D_MODEL // 4
MIX_WIDTH = 4 * GROUP_WIDTH
N_GROUP_HEADS = 4
HEAD_DIM = GROUP_WIDTH // N_GROUP_HEADS
GLA_DK = HEAD_DIM // 2
GLA_QK = N_GROUP_HEADS * GLA_DK
GLA_LOWRANK = 16
GLA_TAU = 16.0
GLA_CHUNK = 64
SC_WIDTH = 3
CF_WIDTH = 31
SG_CHUNK = 128
D_FF = (8 * D_MODEL + 3 * 256 - 1) // (3 * 256) * 256
EPS = 1e-6
IN_SIZES = (GROUP_WIDTH, GROUP_WIDTH, GROUP_WIDTH,
            GLA_QK, GLA_QK, GROUP_WIDTH, GROUP_WIDTH, GLA_LOWRANK,
            2 * GROUP_WIDTH, 2 * GROUP_WIDTH)
N_IN = sum(IN_SIZES)

kernel_name = 'hybrid_conv_gla_conformer_sgu_step'


def _split_points():
    pts, acc = [], 0
    for s in IN_SIZES[:-1]:
        acc += s
        pts.append(acc)
    return pts


def rmsnorm(x, g):
    xf = x.astype(jnp.float32)
    y = xf * lax.rsqrt(jnp.mean(xf * xf, axis=-1, keepdims=True) + EPS) * g.astype(jnp.float32)
    return y.astype(x.dtype)


def layernorm(x, g, b):
    xf = x.astype(jnp.float32)
    mu = jnp.mean(xf, axis=-1, keepdims=True)
    xc = xf - mu
    y = xc * lax.rsqrt(jnp.mean(xc * xc, axis=-1, keepdims=True) + EPS)
    return (y * g.astype(jnp.float32) + b.astype(jnp.float32)).astype(x.dtype)


def causal_dwconv(u, past, w):
    ext = jnp.concatenate([past.astype(u.dtype), u], axis=1)
    y = lax.conv_general_dilated(ext, w[:, None, :].astype(u.dtype), window_strides=(1,),
                                 padding='VALID', dimension_numbers=('NWC', 'WIO', 'NWC'),
                                 feature_group_count=u.shape[-1])
    return y, ext[:, -(w.shape[0] - 1):]


def gla_chunked(q, k, v, log_a, s0, chunk):
    B, L, H, _ = q.shape
    n = L // chunk

    def to_chunks(t):
        return t.reshape(B, n, chunk, H, t.shape[-1]).transpose(1, 0, 3, 2, 4)

    qc, kc, vc, ac = (to_chunks(t) for t in (q, k, v, log_a))
    mask = jnp.tril(jnp.ones((chunk, chunk), dtype=bool))[:, :, None]

    def step(S, inp):
        qi, ki, vi, ai = inp
        b = jnp.cumsum(ai, axis=2)
        diff = b[:, :, :, None, :] - b[:, :, None, :, :]
        decay = jnp.exp(jnp.where(mask, diff, -jnp.inf))
        att = jnp.einsum('bhid,bhjd,bhijd->bhij', qi, ki, decay)
        o = jnp.einsum('bhij,bhjv->bhiv', att, vi) + jnp.einsum('bhid,bhdv->bhiv', qi * jnp.exp(b), S)
        b_last = b[:, :, -1:, :]
        S = jnp.exp(b_last[:, :, 0, :])[..., None] * S + jnp.einsum('bhjd,bhjv->bhdv', ki * jnp.exp(b_last - b), vi)
        return S, o

    S, o = lax.scan(step, s0, (qc, kc, vc, ac))
    o = o.transpose(1, 0, 3, 2, 4).reshape(B, L, H, v.shape[-1])
    return o, S


def mixer_groups(h, past_a, s0, past_c, w_in, conv_a_w, gla_a2, gla_a_bias, gla_norm,
                 conv_c_w, conv_c_b, ln_c_g, ln_c_b, ln_d_g, ln_d_b, sg_w, sg_b, w_o):
    B, L, _ = h.shape
    f32 = jnp.float32
    z = h @ w_in
    a_x, a_b, a_c, g_q, g_k, g_v, g_r, g_lr, c_glu, d_uv = jnp.split(z, _split_points(), axis=-1)

    ya, new_a = causal_dwconv(a_c * a_x, past_a, conv_a_w)
    ya = a_b * ya

    q = (g_q.reshape(B, L, N_GROUP_HEADS, GLA_DK) * (GLA_DK ** -0.5)).astype(f32)
    k = g_k.reshape(B, L, N_GROUP_HEADS, GLA_DK).astype(f32)
    v = g_v.reshape(B, L, N_GROUP_HEADS, HEAD_DIM).astype(f32)
    log_a = jax.nn.log_sigmoid((g_lr @ gla_a2 + gla_a_bias).astype(f32)) / GLA_TAU
    log_a = log_a.reshape(B, L, N_GROUP_HEADS, GLA_DK)
    o, S = gla_chunked(q, k, v, log_a, s0.astype(f32), math.gcd(L, GLA_CHUNK))
    o = o * lax.rsqrt(jnp.mean(o * o, axis=-1, keepdims=True) + EPS)
    o = o * gla_norm.reshape(N_GROUP_HEADS, HEAD_DIM).astype(f32)
    yb = o.reshape(B, L, GROUP_WIDTH).astype(h.dtype) * jax.nn.silu(g_r)

    c_in = c_glu[..., :GROUP_WIDTH] * jax.nn.sigmoid(c_glu[..., GROUP_WIDTH:])
    cc, new_c = causal_dwconv(c_in, past_c, conv_c_w)
    yc = jax.nn.silu(layernorm(cc + conv_c_b, ln_c_g, ln_c_b))

    d = jax.nn.gelu(d_uv)
    u, vd = d[..., :GROUP_WIDTH], d[..., GROUP_WIDTH:]
    vd = layernorm(vd, ln_d_g, ln_d_b)
    c = min(L, SG_CHUNK)
    vr = vd.reshape(B, L // c, c, N_GROUP_HEADS, HEAD_DIM)
    ws = jnp.where(jnp.tril(jnp.ones((c, c), dtype=bool))[None], sg_w[:, :c, :c], 0.0)
    sv = jnp.einsum('hij,bnjhd->bnihd', ws.astype(vr.dtype), vr) + sg_b[:, :c].T[:, :, None]
    yd = u * sv.reshape(B, L, GROUP_WIDTH)

    y = jnp.concatenate([ya, yb, yc, yd], axis=-1) @ w_o
    return y, new_a, S, new_c, vd[:, L - c:]


def swiglu(x, w_gate, w_up, w_down):
    return (jax.nn.silu(x @ w_gate) * (x @ w_up)) @ w_down


def setup_inputs(seed: int = 0) -> dict:
    key = jax.random.key(seed)
    ks = jax.random.split(key, 32)
    nrm = jax.random.normal
    f32 = jnp.float32
    G, H = GROUP_WIDTH, N_GROUP_HEADS
    return {
        'x_prompt': nrm(ks[0], (BATCH, SEQ, D_MODEL), f32),
        'x_sample': nrm(ks[1], (DEC_BATCH, DEC_SEQ, D_MODEL), f32),
        'state_conv_a': nrm(ks[2], (DEPTH, DEC_BATCH, SC_WIDTH - 1, G), f32),
        'state_gla': 0.5 * nrm(ks[3], (DEPTH, DEC_BATCH, H, GLA_DK, HEAD_DIM), f32),
        'state_conv_c': nrm(ks[4], (DEPTH, DEC_BATCH, CF_WIDTH - 1, G), f32),
        'norm_mix': 1.0 + 0.01 * nrm(ks[5], (DEPTH, D_MODEL), f32),
        'w_in': nrm(ks[6], (DEPTH, D_MODEL, N_IN), f32) * D_MODEL ** -0.5,
        'conv_a_w': nrm(ks[7], (DEPTH, SC_WIDTH, G), f32) * SC_WIDTH ** -0.5,
        'gla_a2': nrm(ks[8], (DEPTH, GLA_LOWRANK, GLA_QK), f32) * GLA_LOWRANK ** -0.5,
        'gla_a_bias': 0.1 * nrm(ks[9], (DEPTH, GLA_QK), f32),
        'gla_norm': 1.0 + 0.01 * nrm(ks[10], (DEPTH, G), f32),
        'conv_c_w': nrm(ks[11], (DEPTH, CF_WIDTH, G), f32) * CF_WIDTH ** -0.5,
        'conv_c_b': 0.02 * nrm(ks[12], (DEPTH, G), f32),
        'ln_c_g': 1.0 + 0.01 * nrm(ks[13], (DEPTH, G), f32),
        'ln_c_b': 0.02 * nrm(ks[14], (DEPTH, G), f32),
        'ln_d_g': 1.0 + 0.01 * nrm(ks[15], (DEPTH, G), f32),
        'ln_d_b': 0.02 * nrm(ks[16], (DEPTH, G), f32),
        'sg_w': nrm(ks[17], (DEPTH, H, SG_CHUNK, SG_CHUNK), f32) * SG_CHUNK ** -0.5,
        'sg_b': 1.0 + 0.1 * nrm(ks[18], (DEPTH, H, SG_CHUNK), f32),
        'w_o': nrm(ks[19], (DEPTH, MIX_WIDTH, D_MODEL), f32) * MIX_WIDTH ** -0.5,
        'norm_ffn': 1.0 + 0.01 * nrm(ks[20], (DEPTH, D_MODEL), f32),
        'w_gate': nrm(ks[21], (DEPTH, D_MODEL, D_FF), f32) * D_MODEL ** -0.5,
        'w_up': nrm(ks[22], (DEPTH, D_MODEL, D_FF), f32) * D_MODEL ** -0.5,
        'w_down': nrm(ks[23], (DEPTH, D_FF, D_MODEL), f32) * D_FF ** -0.5,
        'norm_final': 1.0 + 0.01 * nrm(ks[24], (D_MODEL,), f32),
    }


def reference(x_prompt, x_sample, state_conv_a, state_gla, state_conv_c,
              norm_mix, w_in, conv_a_w, gla_a2, gla_a_bias, gla_norm,
              conv_c_w, conv_c_b, ln_c_g, ln_c_b, ln_d_g, ln_d_b, sg_w, sg_b, w_o,
              norm_ffn, w_gate, w_up, w_down, norm_final):

    def trunk(x, pa, ps, pc):
        na, ns, nc, nv = [], [], [], []
        for l in range(DEPTH):
            h = rmsnorm(x, norm_mix[l])
            y, a_new, s_new, c_new, v_new = mixer_groups(
                h, pa[l], ps[l], pc[l], w_in[l], conv_a_w[l], gla_a2[l], gla_a_bias[l], gla_norm[l],
                conv_c_w[l], conv_c_b[l], ln_c_g[l], ln_c_b[l], ln_d_g[l], ln_d_b[l], sg_w[l], sg_b[l], w_o[l])
            x = x + y
            x = x + swiglu(rmsnorm(x, norm_ffn[l]), w_gate[l], w_up[l], w_down[l])
            na.append(a_new.astype(state_conv_a.dtype))
            ns.append(s_new.astype(state_gla.dtype))
            nc.append(c_new.astype(state_conv_c.dtype))
            nv.append(v_new)
        return rmsnorm(x, norm_final), jnp.stack(na), jnp.stack(ns), jnp.stack(nc), jnp.stack(nv)

    zp_a = [jnp.zeros((BATCH, SC_WIDTH - 1, GROUP_WIDTH), x_prompt.dtype)] * DEPTH
    zp_s = [jnp.zeros((BATCH, N_GROUP_HEADS, GLA_DK, HEAD_DIM), jnp.float32)] * DEPTH
    zp_c = [jnp.zeros((BATCH, CF_WIDTH - 1, GROUP_WIDTH), x_prompt.dtype)] * DEPTH
    y_prompt, conv_a_prompt, gla_prompt, conv_c_prompt, sg_v_prompt = trunk(x_prompt, zp_a, zp_s, zp_c)

    y_sample, conv_a_sample, gla_sample, conv_c_sample, sg_v_sample = trunk(
        x_sample,
        [state_conv_a[l] for l in range(DEPTH)],
        [state_gla[l] for l in range(DEPTH)],
        [state_conv_c[l] for l in range(DEPTH)])

    return (y_prompt, y_sample, conv_a_prompt, conv_a_sample, gla_prompt, gla_sample,
            conv_c_prompt, conv_c_sample, sg_v_prompt, sg_v_sample)
```

```cpp
#include <hip/hip_runtime.h>
#include <hip/hip_cooperative_groups.h>
#include <cstdio>
#include <cstdint>
namespace cg = cooperative_groups;

constexpr int DM = 2048, NPROMPT = 8192, MR = 8320, MP = 8448, NIN = 5136, NINP = 5376, DFF = 5632, SEQ = 2048;
constexpr int ZAX = 0, ZAB = 512, ZAC = 1024, ZQ = 1536, ZK = 1792, ZV = 2048, ZR = 2560, ZLR = 3072, ZC = 3088, ZD = 4112;
constexpr float EPS = 1e-6f;

namespace pg8 {
#define PG8_LAS __attribute__((address_space(3)))
typedef unsigned short bf16_t;
typedef short bf16x8 __attribute__((ext_vector_type(8)));
typedef float f32x4 __attribute__((ext_vector_type(4)));
typedef unsigned u32x4 __attribute__((ext_vector_type(4)));
constexpr int BM = 256, BK = 64, HALF = 128, HTB = HALF * BK * 2  , STAGE_BYTES = 8 * HTB, NXCD = 8, WGM = 4;

__host__ __device__ __forceinline__ int lds_byte(int r, int c) { const int st = (r >> 4) * 2 + (c >> 5), rr = r & 15, cc = c & 31, ob = rr * 64 + cc * 2; return st * 1024 + (ob ^ (((ob >> 9) & 1) << 5)); }
__host__ __device__ __forceinline__ void stage_rc(int b, int& R, int& C) { const int st = b / 1024, sb = b % 1024, swz = sb ^ (((sb >> 9) & 1) << 5); R = (st >> 1) * 16 + swz / 64; C = (st & 1) * 32 + (swz % 64) / 2; }
__host__ __device__ __forceinline__ int perm32(int rho) { const int n = rho >> 4, i = rho & 15; return 8 * (i >> 2) + 4 * n + (i & 3); }

struct Unit { int pm, pn, k0, nt, kind; };
struct Gemm { const bf16_t* A; const bf16_t* Bt; int M, N, K; };

struct StaticOrder {
    int nM, nN, nwg, G, c, ntk;
    __host__ __device__ void init(int M, int N, int G_, int c_, int K) { nM = M / BM; nN = N / BM; nwg = nM * nN; G = G_; c = c_; ntk = K / BK; }
    __host__ __device__ bool next(int i, Unit& u) const {
        const long L = (long)i * G + c; if (L >= nwg) return false;
        return at((int)L, u); }
    __host__ __device__ bool at(int wgid, Unit& u) const { { const int q = nwg / NXCD, r = nwg % NXCD, xcd = wgid % NXCD, off = wgid / NXCD; wgid = (xcd < r ? xcd * (q + 1) : r * (q + 1) + (xcd - r) * q) + off; }
        const int nig = WGM * nN, gid = wgid / nig, fm = gid * WGM, gsz = (nM - fm) < WGM ? (nM - fm) : WGM;
        u.pm = fm + ((wgid % nig) % gsz); u.pn = (wgid % nig) / gsz; u.k0 = 0; u.nt = ntk; u.kind = 0; return true;
    }
    __device__ __forceinline__ void a_ready(const Unit&) const {}
    __device__ __forceinline__ void done(const Unit&) const {}
};
struct SplitOrder {
    StaticOrder so; int np, parts, ntp, nsub;
    __host__ __device__ void init(int N, int G_, int c_, int K, int parts_) { so.init(8192, N, G_, c_, K); np = so.nwg; parts = parts_; ntp = K / BK / parts_; nsub = so.nN * parts_; }
    __host__ __device__ bool next(int i, Unit& u) const {
        const long L = (long)i * so.G + so.c; if (L < np) return so.at((int)L, u);
        const int j = (int)(L - np); if (j >= nsub) return false;
        u.pm = 32; u.pn = j % so.nN; u.k0 = (j / so.nN) * ntp * BK; u.nt = ntp; u.kind = 1; return true;
    }
    __device__ __forceinline__ void a_ready(const Unit&) const {}
    __device__ __forceinline__ void done(const Unit&) const {}
};
__device__ __forceinline__ unsigned cvt_pk_bf16(float lo, float hi) { unsigned r; asm volatile("v_cvt_pk_bf16_f32 %0, %1, %2" : "=v"(r) : "v"(lo), "v"(hi)); return r; }
typedef float f32x2 __attribute__((ext_vector_type(2)));


typedef unsigned u32x2 __attribute__((ext_vector_type(2)));
struct EpiZ {
    static constexpr bool PERM = true, AFTER_DRAIN = false;
    bf16_t* Z; int ldz; const float* ssq;
    __device__ __forceinline__ void operator()(const f32x4 (&acc)[2][2][4][2], const Unit& u, int wr, int wc, int fr, int fq) const {
        const int row0 = u.pm * BM + wr * 64 + fr, col0 = u.pn * BM + wc * 32 + 8 * fq;
#pragma unroll
        for (int ai = 0; ai < 2; ++ai)
#pragma unroll
            for (int m = 0; m < 4; ++m) { const int r = row0 + ai * HALF + m * 16; const float rs = rsqrtf(ssq[r] * (1.0f / 2048.0f) + 1e-6f);
                bf16_t* rowp = Z + (size_t)r * ldz + col0;
#pragma unroll
                for (int bj = 0; bj < 2; ++bj) { const f32x4 v0 = acc[ai][bj][m][0] * rs, v1 = acc[ai][bj][m][1] * rs;
                    u32x4 w; w.x = cvt_pk_bf16(v0[0], v0[1]); w.y = cvt_pk_bf16(v0[2], v0[3]); w.z = cvt_pk_bf16(v1[0], v1[1]); w.w = cvt_pk_bf16(v1[2], v1[3]);
                    *(u32x4*)(rowp + bj * HALF) = w; } }
    }
};
struct EpiGU {
    static constexpr bool PERM = true, AFTER_DRAIN = false;
    bf16_t* ACT; int lda; const float* ssq;
    __device__ __forceinline__ void operator()(const f32x4 (&acc)[2][2][4][2], const Unit& u, int wr, int wc, int fr, int fq) const {
        const int row0 = u.pm * BM + wr * 64 + fr, j0 = u.pn * HALF + wc * 32 + 8 * fq;
#pragma unroll
        for (int ai = 0; ai < 2; ++ai)
#pragma unroll
            for (int m = 0; m < 4; ++m) { const int r = row0 + ai * HALF + m * 16; const float rs = rsqrtf(ssq[r] * (1.0f / 2048.0f) + 1e-6f);
                float o[8];
#pragma unroll
                for (int n = 0; n < 2; ++n)
#pragma unroll
                    for (int e = 0; e < 4; ++e) { const float g = acc[ai][0][m][n][e] * rs, uu = acc[ai][1][m][n][e] * rs; o[n * 4 + e] = g * __builtin_amdgcn_rcpf(1.0f + __expf(-g)) * uu; }
                u32x4 w; w.x = cvt_pk_bf16(o[0], o[1]); w.y = cvt_pk_bf16(o[2], o[3]); w.z = cvt_pk_bf16(o[4], o[5]); w.w = cvt_pk_bf16(o[6], o[7]);
                *(u32x4*)(ACT + (size_t)r * lda + j0) = w; }
    }
};
template <int PARTS> struct EpiRes {
    static constexpr bool PERM = false, AFTER_DRAIN = false;
    float* X; bf16_t* XB; float* ssq; unsigned* cnt; int parts; float* part;
    __device__ __forceinline__ void operator()(const f32x4 (&acc)[2][2][4][2], const Unit& u, int wr, int wc, int fr, int fq) const {
        if (u.kind == 0) {
            const int row0 = u.pm * BM + wr * 64 + fr, col0 = u.pn * BM + wc * 32 + 4 * fq;
#pragma unroll
            for (int ai = 0; ai < 2; ++ai)
#pragma unroll
                for (int m = 0; m < 4; ++m) { const int r = row0 + ai * HALF + m * 16; float ss = 0.f;
                    bf16_t* xb = XB + (size_t)r * 2048 + col0;
#pragma unroll
                    for (int bj = 0; bj < 2; ++bj)
#pragma unroll
                        for (int n = 0; n < 2; ++n) { const u32x2 xo = *(const u32x2*)(xb + bj * HALF + n * 16);
                            const f32x4 o = (f32x4){__uint_as_float(xo.x << 16), __uint_as_float(xo.x & 0xffff0000u), __uint_as_float(xo.y << 16), __uint_as_float(xo.y & 0xffff0000u)} + acc[ai][bj][m][n];
                            u32x2 w; w.x = cvt_pk_bf16(o[0], o[1]); w.y = cvt_pk_bf16(o[2], o[3]); *(u32x2*)(xb + bj * HALF + n * 16) = w;
                            ss += (o[0] * o[0] + o[1] * o[1]) + (o[2] * o[2] + o[3] * o[3]); }
                    ss += __shfl_xor(ss, 16); ss += __shfl_xor(ss, 32);
                    if (fq == 0) unsafeAtomicAdd(ssq + r, ss);
                    if (m == 3) asm volatile("" ::: "memory"); }
        } else {
            const int kp = u.k0 / (u.nt * BK); float* P = part + (size_t)kp * 128 * 2048;
            const int rl0 = wr * 64 + fr, col0 = u.pn * BM + wc * 32 + 4 * fq;
#pragma unroll
            for (int m = 0; m < 4; ++m) { float* pr = P + (size_t)(rl0 + m * 16) * 2048 + col0;
#pragma unroll
                for (int bj = 0; bj < 2; ++bj)
#pragma unroll
                    for (int n = 0; n < 2; ++n) { const f32x4 v = acc[0][bj][m][n]; float* q = pr + bj * HALF + n * 16;
                        asm volatile("global_store_dwordx4 %0, %1, off sc1" :: "v"(q), "v"(v) : "memory"); } }
            asm volatile("s_waitcnt vmcnt(0)" ::: "memory");
            const int lane = (int)(threadIdx.x & 63);
            unsigned old = 0u;
            if (lane == 0) old = __hip_atomic_fetch_add(cnt + (u.pn * 8 + wr * 4 + wc), 1u, __ATOMIC_RELAXED, __HIP_MEMORY_SCOPE_AGENT);
            old = (unsigned)__builtin_amdgcn_readfirstlane((int)old);
            if (old == (unsigned)(parts - 1)) {
                __builtin_amdgcn_fence(__ATOMIC_ACQUIRE, "agent"); asm volatile("s_waitcnt vmcnt(0)" ::: "memory");
                const int c4 = (lane & 7) * 4, rg = lane >> 3;
                constexpr int NS = PARTS > 6 ? 1 : 2;
#pragma unroll 1
                for (int rs = 0; rs < 8; ++rs) { const int rl = wr * 64 + rs * 8 + rg; float ss = 0.f;
#pragma unroll 1
                    for (int b0 = 0; b0 < 2; b0 += NS) { f32x4 pv[NS][PARTS + 1];
#pragma unroll
                        for (int bb = 0; bb < NS; ++bb) { const size_t co = (size_t)u.pn * BM + (b0 + bb) * HALF + wc * 32 + c4;
                            pv[bb][PARTS] = *(const f32x4*)(X + (size_t)(8192 + rl) * 2048 + co);
#pragma unroll
                            for (int k = 0; k < PARTS; ++k) pv[bb][k] = *(const f32x4*)(part + ((size_t)k * 128 + rl) * 2048 + co); }
#pragma unroll
                        for (int bb = 0; bb < NS; ++bb) { const size_t xo = (size_t)(8192 + rl) * 2048 + (size_t)u.pn * BM + (b0 + bb) * HALF + wc * 32 + c4; f32x4 o = pv[bb][PARTS];
#pragma unroll
                            for (int k = 0; k < PARTS; ++k) o += pv[bb][k];
                            *(f32x4*)(X + xo) = o; u32x2 w; w.x = cvt_pk_bf16(o[0], o[1]); w.y = cvt_pk_bf16(o[2], o[3]); *(u32x2*)(XB + xo) = w;
                            ss += (o[0] * o[0] + o[1] * o[1]) + (o[2] * o[2] + o[3] * o[3]); } }
                    ss += __shfl_xor(ss, 1); ss += __shfl_xor(ss, 2); ss += __shfl_xor(ss, 4);
                    if ((lane & 7) == 0) unsafeAtomicAdd(ssq + 8192 + rl, ss); }
            }
        }
    }
};

template <class Epi, class Sched, bool ALIGN_EPI = false, bool SP2 = false>
__device__ __forceinline__ void gemm_phase(PG8_LAS unsigned char* lds, const Gemm g, const Sched& S, const Epi& E) {
    int tid_ = threadIdx.x; asm volatile("" : "+v"(tid_));
    const int tid = tid_, wid = __builtin_amdgcn_readfirstlane(tid >> 6), lane = tid & 63, wr = wid >> 2, wc = wid & 3, fr = lane & 15, fq = lane >> 4;
    const int K = g.K;
    unsigned voffA[2], voffB[2];
#pragma unroll
    for (int i = 0; i < 2; ++i) { int R, C; stage_rc(tid * 16 + i * 8192, R, C); const int Rb = Epi::PERM ? ((R & ~31) + perm32(R & 31)) : R;
        voffA[i] = (unsigned)(R * K + C) * 2u; voffB[i] = (unsigned)(Rb * K + C) * 2u; }
    const size_t kstep = (size_t)(BK * 2);
    const size_t hstep = (size_t)HALF * K * 2;
    const size_t tstep = 2 * hstep;
    const unsigned ldsw = (unsigned)wid * 1024u;
    const int aoff = lds_byte(wr * 64 + fr, fq * 8), boff = lds_byte(wc * 32 + fr, fq * 8);
#define PG8_SA(b, h) (((b) * 2 + (h)) * HTB)
#define PG8_SB(b, h) ((4 + (b) * 2 + (h)) * HTB)
#define PG8_STAGE(bufoff, gbase, voff) do { _Pragma("unroll") for (int _i = 0; _i < 2; ++_i) \
        __builtin_amdgcn_global_load_lds((const unsigned*)((const char*)(gbase) + (voff)[_i]), (PG8_LAS unsigned*)(lds + (bufoff) + ldsw + _i * 8192), 16, 0, 0); } while (0)
#define PG8_LDA(dst, b, h) do { _Pragma("unroll") for (int m = 0; m < 4; ++m) _Pragma("unroll") for (int k = 0; k < 2; ++k) dst[m][k] = *(const PG8_LAS bf16x8*)(lds + PG8_SA(b, h) + aoff + m * 2048 + k * 1024); } while (0)
#define PG8_LDB(dst, b, h) do { _Pragma("unroll") for (int n = 0; n < 2; ++n) _Pragma("unroll") for (int k = 0; k < 2; ++k) dst[n][k] = *(const PG8_LAS bf16x8*)(lds + PG8_SB(b, h) + boff + n * 2048 + k * 1024); } while (0)
#define PG8_MMA(ai, bj, At, Bt) do { __builtin_amdgcn_s_setprio(1); _Pragma("unroll") for (int m = 0; m < 4; ++m) _Pragma("unroll") for (int n = 0; n < 2; ++n) _Pragma("unroll") for (int k = 0; k < 2; ++k) \
        acc[ai][bj][m][n] = __builtin_amdgcn_mfma_f32_16x16x32_bf16(Bt[n][k], At[m][k], acc[ai][bj][m][n], 0, 0, 0); __builtin_amdgcn_s_setprio(0); } while (0)
#define PG8_WAIT_V(n) asm volatile("s_waitcnt vmcnt(" #n ")" ::: "memory")
#define PG8_WAIT_L(n) asm volatile("s_waitcnt lgkmcnt(" #n ")" ::: "memory")
#define PG8_BAR __builtin_amdgcn_s_barrier()
#define PG8_SCHED __builtin_amdgcn_sched_barrier(0)
    Unit cur, nxt; int ui = 0;
    if (!S.next(0, cur)) return;
    f32x4 acc[2][2][4][2];
#pragma unroll
    for (int a = 0; a < 2; ++a)
#pragma unroll
        for (int b = 0; b < 2; ++b)
#pragma unroll
            for (int m = 0; m < 4; ++m)
#pragma unroll
                for (int n = 0; n < 2; ++n) acc[a][b][m][n] = (f32x4){0.f, 0.f, 0.f, 0.f};
    bf16x8 At[4][2], B0[2][2], B1[2][2];
    const char* cA = (const char*)g.A + (size_t)cur.pm * tstep + (size_t)cur.k0 * 2; const char* cB = (const char*)g.Bt + (size_t)cur.pn * tstep + (size_t)cur.k0 * 2;
    S.a_ready(cur);
    if constexpr (SP2) {
        PG8_STAGE(PG8_SB(0, 0), cB, voffB); PG8_STAGE(PG8_SB(0, 1), cB + hstep, voffB); PG8_STAGE(PG8_SA(0, 0), cA, voffA); PG8_STAGE(PG8_SA(0, 1), cA + hstep, voffA);
        if (wr == 1) PG8_BAR;
        PG8_WAIT_V(2); PG8_BAR;
        PG8_STAGE(PG8_SB(1, 0), cB + kstep, voffB); PG8_STAGE(PG8_SA(1, 0), cA + kstep, voffA); PG8_STAGE(PG8_SB(1, 1), cB + hstep + kstep, voffB);
        PG8_WAIT_V(6); PG8_BAR;
    } else {
        PG8_STAGE(PG8_SB(0, 0), cB, voffB); PG8_STAGE(PG8_SA(0, 0), cA, voffA); PG8_STAGE(PG8_SB(0, 1), cB + hstep, voffB); PG8_STAGE(PG8_SA(0, 1), cA + hstep, voffA);
        if (wr == 1) PG8_BAR;
        PG8_WAIT_V(4); PG8_BAR;
        PG8_STAGE(PG8_SB(1, 0), cB + kstep, voffB); PG8_STAGE(PG8_SA(1, 0), cA + kstep, voffA); PG8_STAGE(PG8_SB(1, 1), cB + hstep + kstep, voffB);
        PG8_WAIT_V(6); PG8_BAR;
    }
    for (;;) {
        const bool has_next = S.next(ui + 1, nxt);
        const char* nA = has_next ? (const char*)g.A + (size_t)nxt.pm * tstep + (size_t)nxt.k0 * 2 : cA; const char* nB = has_next ? (const char*)g.Bt + (size_t)nxt.pn * tstep + (size_t)nxt.k0 * 2 : cB;
        const int nt = cur.nt;
        for (int t = 0; t < nt; t += 2) {
            const bool last = (t == nt - 2);
            const char* a1 = cA + (size_t)(t + 1) * kstep;
            const char* a2 = last ? nA : cA + (size_t)(t + 2) * kstep; const char* b2 = last ? nB : cB + (size_t)(t + 2) * kstep;
            const char* a3 = a2 + kstep; const char* b3 = b2 + kstep;
            if (last && has_next) S.a_ready(nxt);
            if constexpr (SP2) {
            PG8_LDB(B0, 0, 0); PG8_LDB(B1, 0, 1); PG8_SCHED; PG8_LDA(At, 0, 0); PG8_STAGE(PG8_SA(1, 1), a1 + hstep, voffA);
            PG8_WAIT_V(8); PG8_WAIT_L(0); PG8_BAR; PG8_MMA(0, 0, At, B0); PG8_MMA(0, 1, At, B1); PG8_BAR; PG8_SCHED;
            PG8_LDA(At, 0, 1); PG8_STAGE(PG8_SB(0, 0), b2, voffB); PG8_STAGE(PG8_SB(0, 1), b2 + hstep, voffB); PG8_STAGE(PG8_SA(0, 0), a2, voffA);
            PG8_WAIT_V(8); PG8_WAIT_L(0); PG8_BAR; PG8_MMA(1, 0, At, B0); PG8_MMA(1, 1, At, B1); PG8_BAR; PG8_SCHED;
            PG8_LDB(B0, 1, 0); PG8_LDB(B1, 1, 1); PG8_SCHED; PG8_LDA(At, 1, 0); PG8_STAGE(PG8_SA(0, 1), a2 + hstep, voffA);
            PG8_WAIT_V(8); PG8_WAIT_L(0); PG8_BAR; PG8_MMA(0, 0, At, B0); PG8_MMA(0, 1, At, B1); PG8_BAR; PG8_SCHED;
            PG8_LDA(At, 1, 1); PG8_STAGE(PG8_SB(1, 0), b3, voffB); PG8_STAGE(PG8_SB(1, 1), b3 + hstep, voffB); PG8_STAGE(PG8_SA(1, 0), a3, voffA);
            PG8_WAIT_V(8); PG8_WAIT_L(0); PG8_BAR; PG8_MMA(1, 0, At, B0); PG8_MMA(1, 1, At, B1); PG8_BAR; PG8_SCHED;
            } else {
            PG8_LDB(B0, 0, 0); PG8_SCHED; PG8_LDA(At, 0, 0); PG8_STAGE(PG8_SA(1, 1), a1 + hstep, voffA);
            PG8_WAIT_L(8); PG8_BAR; PG8_WAIT_L(0); PG8_MMA(0, 0, At, B0); PG8_BAR; PG8_SCHED;
            PG8_LDB(B1, 0, 1); PG8_STAGE(PG8_SB(0, 0), b2, voffB);
            PG8_BAR; PG8_WAIT_L(0); PG8_MMA(0, 1, At, B1); PG8_BAR;
            PG8_LDA(At, 0, 1); PG8_STAGE(PG8_SA(0, 0), a2, voffA);
            PG8_BAR; PG8_WAIT_L(0); PG8_MMA(1, 0, At, B0); PG8_BAR; PG8_SCHED;
            PG8_STAGE(PG8_SB(0, 1), b2 + hstep, voffB);
            PG8_WAIT_V(6); PG8_BAR; PG8_MMA(1, 1, At, B1); PG8_BAR;
            PG8_LDB(B0, 1, 0); PG8_SCHED; PG8_LDA(At, 1, 0); PG8_STAGE(PG8_SA(0, 1), a2 + hstep, voffA);
            PG8_WAIT_L(8); PG8_BAR; PG8_WAIT_L(0); PG8_MMA(0, 0, At, B0); PG8_BAR; PG8_SCHED;
            PG8_LDB(B1, 1, 1); PG8_STAGE(PG8_SB(1, 0), b3, voffB);
            PG8_BAR; PG8_WAIT_L(0); PG8_MMA(0, 1, At, B1); PG8_BAR;
            PG8_LDA(At, 1, 1); PG8_STAGE(PG8_SA(1, 0), a3, voffA);
            PG8_BAR; PG8_WAIT_L(0); PG8_MMA(1, 0, At, B0); PG8_BAR; PG8_SCHED;
            PG8_STAGE(PG8_SB(1, 1), b3 + hstep, voffB);
            PG8_WAIT_V(6); PG8_BAR; PG8_MMA(1, 1, At, B1); PG8_BAR;
            }
        }
        if constexpr (ALIGN_EPI) { if (wr == 0) PG8_BAR; }
        if constexpr (!Epi::AFTER_DRAIN) { E(acc, cur, wr, wc, fr, fq); S.done(cur); }
        if (!has_next) break;
#pragma unroll
        for (int a = 0; a < 2; ++a)
#pragma unroll
            for (int b = 0; b < 2; ++b)
#pragma unroll
                for (int m = 0; m < 4; ++m)
#pragma unroll
                    for (int n = 0; n < 2; ++n) acc[a][b][m][n] = (f32x4){0.f, 0.f, 0.f, 0.f};
        cur = nxt; cA = nA; cB = nB; ++ui;
        if constexpr (ALIGN_EPI) { if (wr == 1) PG8_BAR; }
    }
    PG8_WAIT_V(0);
    if constexpr (!ALIGN_EPI) { if (wr == 0) PG8_BAR; }
    PG8_BAR;
    if constexpr (Epi::AFTER_DRAIN) { E.fused(acc, cur, wr, wc, fr, fq, lds, wid, lane); S.done(cur); }
#undef PG8_SA
#undef PG8_SB
#undef PG8_STAGE
#undef PG8_LDA
#undef PG8_LDB
#undef PG8_MMA
#undef PG8_WAIT_V
#undef PG8_WAIT_L
#undef PG8_BAR
#undef PG8_SCHED
}
}


#define LAS __attribute__((address_space(3)))
typedef unsigned short bf16;
typedef float f32x4 __attribute__((ext_vector_type(4)));
typedef float f32x2 __attribute__((ext_vector_type(2)));
typedef unsigned u32x4 __attribute__((ext_vector_type(4)));
typedef unsigned u32x2 __attribute__((ext_vector_type(2)));
constexpr int LDS_BYTES = 147456;
constexpr size_t MiB = 1u << 20;
constexpr size_t WS_SSQ = 0, WS_DEC = 256 * 1024, WS_BAR = 512 * 1024, WS_CNT = 640 * 1024, WS_XB = 1 * MiB, WS_MIX = 34 * MiB, WS_ZACT = 67 * MiB, WS_DS = 158 * MiB, WS_VD = 174 * MiB, WS_W = 182 * MiB;
constexpr size_t WL_IN = 0, WL_O = 21 * MiB, WL_GU = 29 * MiB, WL_D = 73 * MiB, WL_BYTES = 95 * MiB, WL_D1 = 95 * MiB, WS_PART = WS_W + WL_BYTES + 22 * MiB, WS_END = WS_PART + 12 * MiB;
static_assert((size_t)MP * DM * 2 <= 33 * MiB && (size_t)MP * DFF * 2 <= 91 * MiB && (size_t)NINP * DM * 2 <= 21 * MiB && (size_t)2 * DFF * DM * 2 <= 44 * MiB && (size_t)DM * DFF * 2 <= 22 * MiB, "ws map");
constexpr size_t O_Y = 0, O_CAP = 17039360, O_CAS = 17047552, O_GP = 17309696, O_GS = 17571840, O_CCP = 25960448, O_CCS = 26083328, O_SVP = 30015488, O_SVS = 30539776;
enum { I_XP = 0, I_XS, I_SCA, I_SGLA, I_SCC, I_NMIX, I_WIN, I_CAW, I_A2, I_ABIAS, I_GNORM, I_CCW, I_CCB, I_LNCG, I_LNCB, I_LNDG, I_LNDB, I_SGW, I_SGB, I_WO, I_NFFN, I_WG, I_WU, I_WD, I_NFIN };
struct Args { const float* in[25]; float* out; unsigned char* ws; int pad0, pad1; };
typedef const __attribute__((address_space(4))) Args* CA;
__device__ __forceinline__ CA fresh_args() { CA p = (CA)__builtin_amdgcn_kernarg_segment_ptr(); asm volatile("" : "+s"(p)); return p; }

__device__ __forceinline__ float bflo(unsigned w) { return __uint_as_float(w << 16); }
__device__ __forceinline__ float bfhi(unsigned w) { return __uint_as_float(w & 0xffff0000u); }
__device__ __forceinline__ float bf2f(bf16 v) { return __uint_as_float((unsigned)v << 16); }
__device__ __forceinline__ unsigned pk2(float lo, float hi) { return pg8::cvt_pk_bf16(lo, hi); }
__device__ __forceinline__ void ld8(const bf16* p, float (&v)[8]) { const u32x4 w = *(const u32x4*)p; v[0] = bflo(w.x); v[1] = bfhi(w.x); v[2] = bflo(w.y); v[3] = bfhi(w.y); v[4] = bflo(w.z); v[5] = bfhi(w.z); v[6] = bflo(w.w); v[7] = bfhi(w.w); }
__device__ __forceinline__ void up8(const u32x4 w, float (&v)[8]) { v[0] = bflo(w.x); v[1] = bfhi(w.x); v[2] = bflo(w.y); v[3] = bfhi(w.y); v[4] = bflo(w.z); v[5] = bfhi(w.z); v[6] = bflo(w.w); v[7] = bfhi(w.w); }
__device__ __forceinline__ void ld4(const bf16* p, float (&v)[4]) { const u32x2 w = *(const u32x2*)p; v[0] = bflo(w.x); v[1] = bfhi(w.x); v[2] = bflo(w.y); v[3] = bfhi(w.y); }
__device__ __forceinline__ void st8(bf16* p, const float (&v)[8]) { u32x4 w; w.x = pk2(v[0], v[1]); w.y = pk2(v[2], v[3]); w.z = pk2(v[4], v[5]); w.w = pk2(v[6], v[7]); *(u32x4*)p = w; }
__device__ __forceinline__ void ldf8(const float* p, float (&v)[8]) { const f32x4 a = *(const f32x4*)p, b = *(const f32x4*)(p + 4); v[0] = a[0]; v[1] = a[1]; v[2] = a[2]; v[3] = a[3]; v[4] = b[0]; v[5] = b[1]; v[6] = b[2]; v[7] = b[3]; }
__device__ __forceinline__ void stf8(float* p, const float (&v)[8]) { *(f32x4*)p = (f32x4){v[0], v[1], v[2], v[3]}; *(f32x4*)(p + 4) = (f32x4){v[4], v[5], v[6], v[7]}; }
__device__ __forceinline__ float wave_sum(float v) {
#pragma unroll
    for (int o = 1; o < 64; o <<= 1) v += __shfl_xor(v, o);
    return v; }
__device__ __forceinline__ float sigmf(float x) { return __builtin_amdgcn_rcpf(1.0f + __expf(-x)); }
__device__ __forceinline__ float siluf(float x) { return x * __builtin_amdgcn_rcpf(1.0f + __expf(-x)); }
__device__ __forceinline__ float geluf(float x) { const float y = 0.7978845608028654f * (x + 0.044715f * x * x * x); const float t = 1.0f - 2.0f * __builtin_amdgcn_rcpf(__expf(2.0f * y) + 1.0f); return 0.5f * x * (1.0f + t); }
__device__ __forceinline__ float logsigf(float x) { return fminf(x, 0.f) - __logf(1.0f + __expf(-fabsf(x))); }
#define LDS_WAIT() asm volatile("s_waitcnt lgkmcnt(0)" ::: "memory")

__device__ __forceinline__ void tr_item(const float* W, int ldw, int nvalid, const float* gain, bf16* WT, int K, int dst_row0, int k0, int n0, LAS float* scr, int lane) {
    const int nq = (lane & 15) * 4, kr = lane >> 4; const bool ok = (n0 + nq) < nvalid;
    f32x4 v[16];
    const float* src = W + (size_t)(k0 + kr) * ldw + n0 + nq;
#pragma unroll
    for (int i = 0; i < 16; ++i) v[i] = ok ? __builtin_nontemporal_load((const f32x4*)(src + (size_t)(4 * i) * ldw)) : (f32x4){0.f, 0.f, 0.f, 0.f};
    if (gain) {
#pragma unroll
        for (int i = 0; i < 16; ++i) v[i] *= gain[k0 + 4 * i + kr]; }
#pragma unroll
    for (int i = 0; i < 16; ++i) { LAS float* d = scr + (4 * i + kr) * 65 + nq; d[0] = v[i][0]; d[1] = v[i][1]; d[2] = v[i][2]; d[3] = v[i][3]; }
    LDS_WAIT(); asm volatile("" ::: "memory");
    const int c = lane >> 3, nn0 = lane & 7;
#pragma unroll
    for (int j = 0; j < 8; ++j) { const int nn = nn0 + 8 * j; const LAS float* s = scr + (8 * c) * 65 + nn;
        u32x4 o; o.x = pk2(s[0 * 65], s[1 * 65]); o.y = pk2(s[2 * 65], s[3 * 65]); o.z = pk2(s[4 * 65], s[5 * 65]); o.w = pk2(s[6 * 65], s[7 * 65]);
        __builtin_nontemporal_store(o, (u32x4*)(WT + (size_t)(dst_row0 + nn) * K + k0 + 8 * c)); }
    LDS_WAIT(); asm volatile("" ::: "memory");
}
__device__ __forceinline__ void p0_prologue(CA a, int l, LAS unsigned char* lds, int gw, int NGW, int wave, int lane) {
    LAS float* scr = (LAS float*)(lds + wave * 16640);
    unsigned char* ws = a->ws;
    constexpr int I_IN = 32 * 84, I_O = 32 * 32, I_G = 32 * 88, I_D = 88 * 32, PER_L = I_IN + I_O + 2 * I_G + I_D;
    unsigned char* wl = ws + WS_W;
    for (int it = gw; it < PER_L; it += NGW) {
        int r = it;
        if (r < I_IN) { const int kb = r / 84, nb = r % 84; tr_item(a->in[I_WIN] + (size_t)l * DM * NIN, NIN, NIN, a->in[I_NMIX] + l * DM, (bf16*)(wl + WL_IN), DM, 64 * nb, 64 * kb, 64 * nb, scr, lane); continue; } r -= I_IN;
        if (r < I_O) { const int kb = r / 32, nb = r % 32; tr_item(a->in[I_WO] + (size_t)l * DM * DM, DM, DM, nullptr, (bf16*)(wl + WL_O), DM, 64 * nb, 64 * kb, 64 * nb, scr, lane); continue; } r -= I_O;
        if (r < I_G) { const int kb = r / 88, nb = r % 88, n0 = 64 * nb; tr_item(a->in[I_WG] + (size_t)l * DM * DFF, DFF, DFF, a->in[I_NFFN] + l * DM, (bf16*)(wl + WL_GU), DM, (n0 >> 7) * 256 + (n0 & 127), 64 * kb, n0, scr, lane); continue; } r -= I_G;
        if (r < I_G) { const int kb = r / 88, nb = r % 88, n0 = 64 * nb; tr_item(a->in[I_WU] + (size_t)l * DM * DFF, DFF, DFF, a->in[I_NFFN] + l * DM, (bf16*)(wl + WL_GU), DM, (n0 >> 7) * 256 + 128 + (n0 & 127), 64 * kb, n0, scr, lane); continue; } r -= I_G;
        { const int kb = r / 32, nb = r % 32; tr_item(a->in[I_WD] + (size_t)l * DFF * DM, DM, DM, nullptr, (bf16*)(wl + (l ? WL_D1 : WL_D)), DFF, 64 * nb, 64 * kb, 64 * nb, scr, lane); }
    }
    if (l != 0) return;
    float* X = a->out + O_Y; bf16* XB = (bf16*)(ws + WS_XB); float* ssq = (float*)(ws + WS_SSQ);
    for (int r0 = gw * 2; r0 < MP; r0 += NGW * 2) {
        f32x4 v[2][8];
#pragma unroll
        for (int q = 0; q < 2; ++q) { const int r = r0 + q; const float* src = r < NPROMPT ? a->in[I_XP] + (size_t)r * DM : a->in[I_XS] + (size_t)(r - NPROMPT) * DM;
#pragma unroll
            for (int j = 0; j < 8; ++j) v[q][j] = r < MR ? *(const f32x4*)(src + 256 * j + 4 * lane) : (f32x4){0.f, 0.f, 0.f, 0.f}; }
#pragma unroll
        for (int q = 0; q < 2; ++q) { const int r = r0 + q; float ss = 0.f;
#pragma unroll
            for (int j = 0; j < 8; ++j) { const f32x4 x = v[q][j]; if (r >= NPROMPT && r < MR) *(f32x4*)(X + (size_t)r * DM + 256 * j + 4 * lane) = x;
                u32x2 w; w.x = pk2(x[0], x[1]); w.y = pk2(x[2], x[3]); *(u32x2*)(XB + (size_t)r * DM + 256 * j + 4 * lane) = w;
                ss += (x[0] * x[0] + x[1] * x[1]) + (x[2] * x[2] + x[3] * x[3]); }
            ss = wave_sum(ss);
            if (lane < 5) ssq[lane * MP + r] = lane == 0 ? ss : 0.f; }
    }
}

constexpr int OFF_B = 0, OFF_QT = 4160, OFF_KT = 8512, OFF_AT = 12864, OFF_V = 17216, OFF_S = 25408;
__device__ __forceinline__ void gla_b(CA a, int l, const bf16* Z, int row0, int h, LAS float* Bm, LAS float* G, int tid) {
    LAS float* glr = G; LAS float* A2h = G + 1024; LAS float* bia = G + 2048; LAS float* seg = G + 2112;
    for (int e = tid; e < 1024; e += 512) { const int i = e >> 4, r = e & 15; glr[e] = bf2f(Z[(size_t)(row0 + i) * NINP + ZLR + r]); }
    for (int e = tid; e < 1024; e += 512) { const int r = e >> 6, d = e & 63; A2h[e] = a->in[I_A2][(l * 16 + r) * 256 + h * 64 + d]; }
    if (tid < 64) bia[tid] = a->in[I_ABIAS][l * 256 + h * 64 + tid];
    __syncthreads();
    { const int i = tid >> 3, d0 = (tid & 7) * 8; float acc[8];
#pragma unroll
        for (int e = 0; e < 8; ++e) acc[e] = bia[d0 + e];
#pragma unroll
        for (int r = 0; r < 16; ++r) { const float g = glr[i * 16 + r];
#pragma unroll
            for (int e = 0; e < 8; ++e) acc[e] += g * A2h[r * 64 + d0 + e]; }
#pragma unroll
        for (int e = 0; e < 8; ++e) Bm[i * 65 + d0 + e] = logsigf(acc[e]) * (1.0f / 16.0f); }
    __syncthreads();
    const int sg = tid >> 6, d = tid & 63;
    { float run = 0.f;
#pragma unroll
        for (int k = 0; k < 8; ++k) { run += Bm[(sg * 8 + k) * 65 + d]; Bm[(sg * 8 + k) * 65 + d] = run; }
        seg[sg * 64 + d] = run; }
    __syncthreads();
    { float pre = 0.f;
#pragma unroll
        for (int s = 0; s < 7; ++s) if (s < sg) pre += seg[s * 64 + d];
#pragma unroll
        for (int k = 0; k < 8; ++k) Bm[(sg * 8 + k) * 65 + d] += pre; }
    __syncthreads();
}

__device__ __forceinline__ void p2_gla_ds(CA a, int l, int it, LAS unsigned char* lds, int tid) {
    a = fresh_args();
    const int b = it >> 7, c = (it >> 2) & 31, h = it & 3, row0 = b * SEQ + c * 64;
    const bf16* Z = (const bf16*)(a->ws + WS_ZACT);
    LAS float* L = (LAS float*)lds; LAS float* Bm = L + OFF_B; LAS float* KP = L + OFF_QT; LAS float* V = L + OFF_V;
    __syncthreads();
    gla_b(a, l, Z, row0, h, Bm, L + OFF_AT, tid);
    { const int j = tid >> 3, dg = tid & 7; float kv[8], vv[8];
        ld8(Z + (size_t)(row0 + j) * NINP + ZK + h * 64 + dg * 8, kv);
#pragma unroll
        for (int e = 0; e < 8; ++e) KP[j * 68 + dg * 8 + e] = kv[e] * __expf(Bm[63 * 65 + dg * 8 + e] - Bm[j * 65 + dg * 8 + e]);
        ld8(Z + (size_t)(row0 + j) * NINP + ZV + h * 128 + dg * 16, vv);
#pragma unroll
        for (int e = 0; e < 8; ++e) V[j * 128 + dg * 16 + e] = vv[e];
        ld8(Z + (size_t)(row0 + j) * NINP + ZV + h * 128 + dg * 16 + 8, vv);
#pragma unroll
        for (int e = 0; e < 8; ++e) V[j * 128 + dg * 16 + 8 + e] = vv[e]; }
    __syncthreads();
    { const int d0 = (tid >> 5) * 4, v0 = (tid & 31) * 4; f32x4 acc[4];
#pragma unroll
        for (int x = 0; x < 4; ++x) acc[x] = (f32x4){0.f, 0.f, 0.f, 0.f};
#pragma unroll 4
        for (int j = 0; j < 64; ++j) { const f32x4 k4 = *(const LAS f32x4*)(KP + j * 68 + d0), v4 = *(const LAS f32x4*)(V + j * 128 + v0);
#pragma unroll
            for (int x = 0; x < 4; ++x) acc[x] += k4[x] * v4; }
        float* DS = (float*)(a->ws + WS_DS) + (size_t)it * 8192;
#pragma unroll
        for (int x = 0; x < 4; ++x) *(f32x4*)(DS + (d0 + x) * 128 + v0) = acc[x]; }
    if (tid < 64) ((float*)(a->ws + WS_DEC))[it * 64 + tid] = __expf(Bm[63 * 65 + tid]);
}

typedef short mf_bf16x8 __attribute__((ext_vector_type(8)));
__device__ __forceinline__ void p4_gla_o(CA a, int l, int it, LAS unsigned char* lds, int tid) {
    a = fresh_args();
    const int b = it >> 7, c = (it >> 2) & 31, h = it & 3, row0 = b * SEQ + c * 64;
    const bf16* Z = (const bf16*)(a->ws + WS_ZACT); bf16* MIX = (bf16*)(a->ws + WS_MIX);
    LAS float* L = (LAS float*)lds; LAS float* Bm = L; LAS float* G = L + 4160;
    LAS bf16* Qp = (LAS bf16*)(L + 4160 + 4224); LAS bf16* Kp = Qp + 64 * 72; LAS bf16* Vt = Kp + 64 * 72; LAS bf16* St = Vt + 128 * 72; LAS float* SS = (LAS float*)(St + 128 * 72);
    LAS bf16* ATT = (LAS bf16*)G;
    __syncthreads();
    gla_b(a, l, Z, row0, h, Bm, G, tid);
    { const int i = tid & 63, dg = tid >> 6; float qv[8], kv[8];
        ld8(Z + (size_t)(row0 + i) * NINP + ZQ + h * 64 + dg * 8, qv); ld8(Z + (size_t)(row0 + i) * NINP + ZK + h * 64 + dg * 8, kv);
#pragma unroll
        for (int e = 0; e < 8; ++e) { const float bb = Bm[i * 65 + dg * 8 + e]; qv[e] *= 0.125f * __expf(bb); kv[e] *= __expf(-bb); }
        u32x4 w; w.x = pk2(qv[0], qv[1]); w.y = pk2(qv[2], qv[3]); w.z = pk2(qv[4], qv[5]); w.w = pk2(qv[6], qv[7]); *(LAS u32x4*)(Qp + i * 72 + dg * 8) = w;
        w.x = pk2(kv[0], kv[1]); w.y = pk2(kv[2], kv[3]); w.z = pk2(kv[4], kv[5]); w.w = pk2(kv[6], kv[7]); *(LAS u32x4*)(Kp + i * 72 + dg * 8) = w; }
    { u32x4 vr[2]; f32x4 sr[4]; const float* Sg = (const float*)(a->ws + WS_DS) + (size_t)it * 8192;
#pragma unroll
        for (int q = 0; q < 2; ++q) { const int idx = tid + q * 512, j = idx & 63, dv8 = (idx >> 6) * 8; vr[q] = *(const u32x4*)(Z + (size_t)(row0 + j) * NINP + ZV + h * 128 + dv8); }
#pragma unroll
        for (int q = 0; q < 4; ++q) { const int idx = tid + q * 512, d = idx & 63, dv4 = (idx >> 6) * 4; sr[q] = *(const f32x4*)(Sg + d * 128 + dv4); }
#pragma unroll
        for (int q = 0; q < 2; ++q) { const int idx = tid + q * 512, j = idx & 63, dv8 = (idx >> 6) * 8; const unsigned ww[4] = {vr[q].x, vr[q].y, vr[q].z, vr[q].w};
#pragma unroll
            for (int e = 0; e < 4; ++e) { Vt[(dv8 + 2 * e) * 72 + j] = (bf16)(ww[e] & 0xffffu); Vt[(dv8 + 2 * e + 1) * 72 + j] = (bf16)(ww[e] >> 16); } }
#pragma unroll
        for (int q = 0; q < 4; ++q) { const int idx = tid + q * 512, d = idx & 63, dv4 = (idx >> 6) * 4; const unsigned p0 = pk2(sr[q][0], sr[q][1]), p1 = pk2(sr[q][2], sr[q][3]);
            St[(dv4 + 0) * 72 + d] = (bf16)(p0 & 0xffffu); St[(dv4 + 1) * 72 + d] = (bf16)(p0 >> 16); St[(dv4 + 2) * 72 + d] = (bf16)(p1 & 0xffffu); St[(dv4 + 3) * 72 + d] = (bf16)(p1 >> 16); } }
    __syncthreads();
    const int wv = tid >> 6, lane = tid & 63, fr = lane & 15, fq = lane >> 4, mi = wv >> 1, nh = wv & 1;
    {
        const mf_bf16x8 a0 = *(const LAS mf_bf16x8*)(Qp + (16 * mi + fr) * 72 + 8 * fq), a1 = *(const LAS mf_bf16x8*)(Qp + (16 * mi + fr) * 72 + 32 + 8 * fq);
#pragma unroll
        for (int t = 0; t < 2; ++t) { const int nj = 2 * nh + t; f32x4 at = (f32x4){0.f, 0.f, 0.f, 0.f};
            at = __builtin_amdgcn_mfma_f32_16x16x32_bf16(*(const LAS mf_bf16x8*)(Kp + (16 * nj + fr) * 72 + 8 * fq), a0, at, 0, 0, 0);
            at = __builtin_amdgcn_mfma_f32_16x16x32_bf16(*(const LAS mf_bf16x8*)(Kp + (16 * nj + fr) * 72 + 32 + 8 * fq), a1, at, 0, 0, 0);
            const int i = 16 * mi + fr, j0 = 16 * nj + 4 * fq; u32x2 w;
            w.x = pk2(j0 <= i ? at[0] : 0.f, j0 + 1 <= i ? at[1] : 0.f); w.y = pk2(j0 + 2 <= i ? at[2] : 0.f, j0 + 3 <= i ? at[3] : 0.f);
            *(LAS u32x2*)(ATT + i * 72 + j0) = w; } }
    __syncthreads();
    f32x4 acc[4];
#pragma unroll
    for (int t = 0; t < 4; ++t) acc[t] = (f32x4){0.f, 0.f, 0.f, 0.f};
    const int nks1 = mi < 2 ? 1 : 2;
    for (int ks = 0; ks < nks1; ++ks) { const mf_bf16x8 af = *(const LAS mf_bf16x8*)(ATT + (16 * mi + fr) * 72 + 32 * ks + 8 * fq);
#pragma unroll
        for (int t = 0; t < 4; ++t) acc[t] = __builtin_amdgcn_mfma_f32_16x16x32_bf16(*(const LAS mf_bf16x8*)(Vt + (16 * (4 * nh + t) + fr) * 72 + 32 * ks + 8 * fq), af, acc[t], 0, 0, 0); }
#pragma unroll
    for (int ks = 0; ks < 2; ++ks) { const mf_bf16x8 af = *(const LAS mf_bf16x8*)(Qp + (16 * mi + fr) * 72 + 32 * ks + 8 * fq);
#pragma unroll
        for (int t = 0; t < 4; ++t) acc[t] = __builtin_amdgcn_mfma_f32_16x16x32_bf16(*(const LAS mf_bf16x8*)(St + (16 * (4 * nh + t) + fr) * 72 + 32 * ks + 8 * fq), af, acc[t], 0, 0, 0); }
    { float ss = 0.f;
#pragma unroll
        for (int t = 0; t < 4; ++t) ss += (acc[t][0] * acc[t][0] + acc[t][1] * acc[t][1]) + (acc[t][2] * acc[t][2] + acc[t][3] * acc[t][3]);
        ss += __shfl_xor(ss, 16); ss += __shfl_xor(ss, 32);
        if (fq == 0) SS[(16 * mi + fr) * 2 + nh] = ss; }
    __syncthreads();
    { const int i = 16 * mi + fr; const size_t row = (size_t)(row0 + i); const float rs = rsqrtf((SS[i * 2] + SS[i * 2 + 1]) * (1.0f / 128.0f) + EPS);
#pragma unroll
        for (int t = 0; t < 4; ++t) { const int dv = 16 * (4 * nh + t) + 4 * fq; const f32x4 gn = *(const f32x4*)(a->in[I_GNORM] + l * 512 + h * 128 + dv);
            float gr[4]; ld4(Z + row * NINP + ZR + h * 128 + dv, gr);
            u32x2 w; w.x = pk2(acc[t][0] * rs * gn[0] * siluf(gr[0]), acc[t][1] * rs * gn[1] * siluf(gr[1])); w.y = pk2(acc[t][2] * rs * gn[2] * siluf(gr[2]), acc[t][3] * rs * gn[3] * siluf(gr[3]));
            *(u32x2*)(MIX + row * DM + 512 + h * 128 + dv) = w; } }
}

__device__ __forceinline__ void p4_sgu(CA a, int l, int it, LAS unsigned char* lds, int tid) {
    a = fresh_args();
    const int b = it >> 6, n = (it >> 2) & 15, h = it & 3, row0 = b * SEQ + n * 128;
    const bf16* Z = (const bf16*)(a->ws + WS_ZACT); bf16* MIX = (bf16*)(a->ws + WS_MIX); const bf16* VD = (const bf16*)(a->ws + WS_VD);
    LAS bf16* Wb = (LAS bf16*)lds; LAS bf16* Vt = Wb + 128 * 136;
    __syncthreads();
    const float* sgw = a->in[I_SGW] + (size_t)(l * 4 + h) * 128 * 128;
    { f32x4 w[8]; u32x4 vr[4];
#pragma unroll
        for (int q = 0; q < 8; ++q) { const int ch = tid + q * 512, i = ch >> 5, j4 = (ch & 31) * 4; w[q] = *(const f32x4*)(sgw + i * 128 + j4); }
#pragma unroll
        for (int q = 0; q < 4; ++q) { const int ch = tid + q * 512, j = ch & 127, d8 = (ch >> 7) * 8; vr[q] = *(const u32x4*)(VD + (size_t)(row0 + j) * 512 + h * 128 + d8); }
#pragma unroll
        for (int q = 0; q < 8; ++q) { const int ch = tid + q * 512, i = ch >> 5, j4 = (ch & 31) * 4; f32x4 v = w[q];
#pragma unroll
            for (int e = 0; e < 4; ++e) v[e] = (j4 + e <= i) ? v[e] : 0.f;
            u32x2 o; o.x = pk2(v[0], v[1]); o.y = pk2(v[2], v[3]); *(LAS u32x2*)(Wb + i * 136 + j4) = o; }
#pragma unroll
        for (int q = 0; q < 4; ++q) { const int ch = tid + q * 512, j = ch & 127, d8 = (ch >> 7) * 8; const unsigned ww[4] = {vr[q].x, vr[q].y, vr[q].z, vr[q].w};
#pragma unroll
            for (int e = 0; e < 4; ++e) { Vt[(d8 + 2 * e) * 136 + j] = (bf16)(ww[e] & 0xffffu); Vt[(d8 + 2 * e + 1) * 136 + j] = (bf16)(ww[e] >> 16); } } }
    __syncthreads();
    const int wv = tid >> 6, lane = tid & 63, fr = lane & 15, fq = lane >> 4;
    f32x4 acc[8];
#pragma unroll
    for (int nt = 0; nt < 8; ++nt) acc[nt] = (f32x4){0.f, 0.f, 0.f, 0.f};
    const int nks = (16 * wv + 15) / 32 + 1;
    for (int ks = 0; ks < nks; ++ks) { const mf_bf16x8 af = *(const LAS mf_bf16x8*)(Wb + (16 * wv + fr) * 136 + 32 * ks + 8 * fq);
#pragma unroll
        for (int nt = 0; nt < 8; ++nt) { const mf_bf16x8 bfr = *(const LAS mf_bf16x8*)(Vt + (16 * nt + fr) * 136 + 32 * ks + 8 * fq);
            acc[nt] = __builtin_amdgcn_mfma_f32_16x16x32_bf16(bfr, af, acc[nt], 0, 0, 0); } }
    { const int i = 16 * wv + fr; const size_t row = (size_t)(row0 + i); const float bs = a->in[I_SGB][(l * 4 + h) * 128 + i];
#pragma unroll
        for (int nt = 0; nt < 8; ++nt) { const int d = 16 * nt + 4 * fq; float up[4]; ld4(Z + row * NINP + ZD + h * 128 + d, up);
            u32x2 o; o.x = pk2(geluf(up[0]) * (acc[nt][0] + bs), geluf(up[1]) * (acc[nt][1] + bs)); o.y = pk2(geluf(up[2]) * (acc[nt][2] + bs), geluf(up[3]) * (acc[nt][3] + bs));
            *(u32x2*)(MIX + row * DM + 1536 + h * 128 + d) = o; } }
}

__device__ __forceinline__ void p2_conf(CA a, int l, int it, LAS unsigned char* lds, int tid, int wave, int lane) {
    a = fresh_args();
    const int b = it >> 6, tile = it & 63, t0 = tile * 32;
    const bf16* Z = (const bf16*)(a->ws + WS_ZACT); bf16* MIX = (bf16*)(a->ws + WS_MIX);
    LAS float* CIN = (LAS float*)lds;
    float w[31]; const float* cw = a->in[I_CCW] + (size_t)l * 31 * 512 + tid;
#pragma unroll
    for (int j = 0; j < 31; ++j) w[j] = cw[j * 512];
    const float bsv = a->in[I_CCB][l * 512 + tid];
    __syncthreads();
    { const int rr = tid >> 6, c8 = (tid & 63) * 8; u32x4 ga[8], gb[8];
#pragma unroll
        for (int p = 0; p < 8; ++p) { const int i = p * 8 + rr, t = t0 - 30 + i; ga[p] = (u32x4){0u, 0u, 0u, 0u}; gb[p] = ga[p];
            if (i < 62 && t >= 0) { const bf16* zr = Z + (size_t)(b * SEQ + t) * NINP + ZC + c8; ga[p] = *(const u32x4*)zr; gb[p] = *(const u32x4*)(zr + 512); } }
#pragma unroll
        for (int p = 0; p < 8; ++p) { const int i = p * 8 + rr; if (i < 62) { float fa[8], fb[8], cv[8]; up8(ga[p], fa); up8(gb[p], fb);
#pragma unroll
                for (int e = 0; e < 8; ++e) cv[e] = fa[e] * sigmf(fb[e]);
                *(LAS f32x4*)(CIN + i * 512 + c8) = (f32x4){cv[0], cv[1], cv[2], cv[3]}; *(LAS f32x4*)(CIN + i * 512 + c8 + 4) = (f32x4){cv[4], cv[5], cv[6], cv[7]};
                if (tile == 63 && i >= 32) stf8(a->out + O_CCP + ((size_t)(l * 4 + b) * 30 + (i - 32)) * 512 + c8, cv); } } }
    __syncthreads();
    { const int c = tid; float acc[32];
#pragma unroll
        for (int t = 0; t < 32; ++t) acc[t] = bsv;
#pragma unroll
        for (int i = 0; i < 62; ++i) { const float v = CIN[i * 512 + c];
#pragma unroll
            for (int t = 0; t < 32; ++t) { if (i - t >= 0 && i - t <= 30) acc[t] += w[i - t] * v; } }
        __syncthreads();
#pragma unroll
        for (int t = 0; t < 32; ++t) CIN[t * 512 + c] = acc[t]; }
    __syncthreads();
    { float g[8], bt[8]; ldf8(a->in[I_LNCG] + l * 512 + lane * 8, g); ldf8(a->in[I_LNCB] + l * 512 + lane * 8, bt);
#pragma unroll
        for (int rr = 0; rr < 4; ++rr) { const int t = wave * 4 + rr; float v[8];
            { const f32x4 x0 = *(const LAS f32x4*)(CIN + t * 512 + lane * 8), x1 = *(const LAS f32x4*)(CIN + t * 512 + lane * 8 + 4); v[0] = x0[0]; v[1] = x0[1]; v[2] = x0[2]; v[3] = x0[3]; v[4] = x1[0]; v[5] = x1[1]; v[6] = x1[2]; v[7] = x1[3]; }
            float s = 0.f;
#pragma unroll
            for (int e = 0; e < 8; ++e) s += v[e];
            const float mu = wave_sum(s) * (1.0f / 512.0f); float q = 0.f;
#pragma unroll
            for (int e = 0; e < 8; ++e) { v[e] -= mu; q += v[e] * v[e]; }
            const float rstd = rsqrtf(wave_sum(q) * (1.0f / 512.0f) + EPS); float y[8];
#pragma unroll
            for (int e = 0; e < 8; ++e) y[e] = siluf(v[e] * rstd * g[e] + bt[e]);
            st8(MIX + (size_t)(b * SEQ + t0 + t) * DM + 1024 + lane * 8, y); } }
}
__device__ __forceinline__ void p2_conf_sample_w(CA a, int l, int s, int lane) {
    a = fresh_args();
    const bf16* Z = (const bf16*)(a->ws + WS_ZACT); bf16* MIX = (bf16*)(a->ws + WS_MIX);
    const int c8 = lane * 8; const size_t row = (size_t)(NPROMPT + s);
    float ga[8], gb[8], cin[8], acc[8], w[8];
    ld8(Z + row * NINP + ZC + c8, ga); ld8(Z + row * NINP + ZC + 512 + c8, gb);
    const float* cw = a->in[I_CCW] + (size_t)l * 31 * 512 + c8; ldf8(a->in[I_CCB] + l * 512 + c8, acc); ldf8(cw + 30 * 512, w);
#pragma unroll
    for (int e = 0; e < 8; ++e) { cin[e] = ga[e] * sigmf(gb[e]); acc[e] += w[e] * cin[e]; }
    const float* past = a->in[I_SCC] + ((size_t)(l * 128 + s) * 30) * 512 + c8; float* nc = a->out + O_CCS + ((size_t)(l * 128 + s) * 30) * 512 + c8;
#pragma unroll 1
    for (int jb = 0; jb < 30; jb += 6) { float pv[6][8], wv[6][8];
#pragma unroll
        for (int j = 0; j < 6; ++j) { ldf8(past + (jb + j) * 512, pv[j]); ldf8(cw + (jb + j) * 512, wv[j]); }
#pragma unroll
        for (int j = 0; j < 6; ++j) {
#pragma unroll
            for (int e = 0; e < 8; ++e) acc[e] += wv[j][e] * pv[j][e];
            if (jb + j >= 1) stf8(nc + (jb + j - 1) * 512, pv[j]); } }
    stf8(nc + 29 * 512, cin);
    float sm = 0.f;
#pragma unroll
    for (int e = 0; e < 8; ++e) sm += acc[e];
    const float mu = wave_sum(sm) * (1.0f / 512.0f); float q = 0.f;
#pragma unroll
    for (int e = 0; e < 8; ++e) { acc[e] -= mu; q += acc[e] * acc[e]; }
    const float rstd = rsqrtf(wave_sum(q) * (1.0f / 512.0f) + EPS); float g[8], bt[8], y[8];
    ldf8(a->in[I_LNCG] + l * 512 + c8, g); ldf8(a->in[I_LNCB] + l * 512 + c8, bt);
#pragma unroll
    for (int e = 0; e < 8; ++e) y[e] = siluf(acc[e] * rstd * g[e] + bt[e]);
    st8(MIX + row * DM + 1024 + c8, y);
}
__device__ __forceinline__ void p2_gla_sample_w(CA a, int l, int it, int lane) {
    a = fresh_args();
    const int s = it >> 2, h = it & 3; const size_t row = (size_t)(NPROMPT + s);
    const bf16* Z = (const bf16*)(a->ws + WS_ZACT); bf16* MIX = (bf16*)(a->ws + WS_MIX);
    float acc = a->in[I_ABIAS][l * 256 + h * 64 + lane];
    { float g[8], g2[8]; ld8(Z + row * NINP + ZLR, g); ld8(Z + row * NINP + ZLR + 8, g2);
#pragma unroll
        for (int r = 0; r < 8; ++r) acc += g[r] * a->in[I_A2][(l * 16 + r) * 256 + h * 64 + lane];
#pragma unroll
        for (int r = 0; r < 8; ++r) acc += g2[r] * a->in[I_A2][(l * 16 + 8 + r) * 256 + h * 64 + lane]; }
    const float av = __expf(logsigf(acc) * (1.0f / 16.0f)), qv = bf2f(Z[row * NINP + ZQ + h * 64 + lane]) * 0.125f, kv = bf2f(Z[row * NINP + ZK + h * 64 + lane]);
    const unsigned vw = *(const unsigned*)(Z + row * NINP + ZV + h * 128 + lane * 2); const float v0 = bflo(vw), v1 = bfhi(vw);
    const size_t so = ((size_t)((l * 128 + s) * 4 + h) * 64) * 128;
    const float* S0 = a->in[I_SGLA] + so + lane * 2; float* Sn = a->out + O_GS + so + lane * 2; float o0 = 0.f, o1 = 0.f;
#pragma unroll 1
    for (int db = 0; db < 64; db += 32) { f32x2 sv[32];
#pragma unroll
        for (int j = 0; j < 32; ++j) sv[j] = *(const f32x2*)(S0 + (db + j) * 128);
#pragma unroll
        for (int j = 0; j < 32; ++j) { const int d = db + j;
            const float ad = __int_as_float(__builtin_amdgcn_readlane(__float_as_int(av), d)), kd = __int_as_float(__builtin_amdgcn_readlane(__float_as_int(kv), d)), qd = __int_as_float(__builtin_amdgcn_readlane(__float_as_int(qv), d));
            f32x2 t; t.x = ad * sv[j].x + kd * v0; t.y = ad * sv[j].y + kd * v1; *(f32x2*)(Sn + d * 128) = t; o0 += qd * t.x; o1 += qd * t.y; } }
    const float rs = rsqrtf(wave_sum(o0 * o0 + o1 * o1) * (1.0f / 128.0f) + EPS);
    const float g0 = a->in[I_GNORM][l * 512 + h * 128 + lane * 2], g1 = a->in[I_GNORM][l * 512 + h * 128 + lane * 2 + 1];
    const unsigned grw = *(const unsigned*)(Z + row * NINP + ZR + h * 128 + lane * 2);
    *(unsigned*)(MIX + row * DM + 512 + h * 128 + lane * 2) = pk2(o0 * rs * g0 * siluf(bflo(grw)), o1 * rs * g1 * siluf(bfhi(grw)));
}
struct RowIn { u32x4 ax, ac, ab, ax1, ac1, ax2, ac2, vv, uu; };
__device__ __forceinline__ void p2_row_load(CA a, int l, int r, int lane, RowIn& R) {
    a = fresh_args();
    const bf16* zr = (const bf16*)(a->ws + WS_ZACT) + (size_t)r * NINP; const int c0 = lane * 8; const bool smp = r >= NPROMPT; const int t = r & 2047, s = r - NPROMPT;
    const u32x4 z4 = (u32x4){0u, 0u, 0u, 0u};
    R.ax = *(const u32x4*)(zr + ZAX + c0); R.ac = *(const u32x4*)(zr + ZAC + c0); R.ab = *(const u32x4*)(zr + ZAB + c0); R.vv = *(const u32x4*)(zr + ZD + 512 + c0);
    R.ax1 = z4; R.ac1 = z4; R.ax2 = z4; R.ac2 = z4; R.uu = z4;
    if (smp) { const float* st = a->in[I_SCA] + ((size_t)(l * 128 + s) * 2) * 512 + c0; R.ax2 = *(const u32x4*)st; R.ac2 = *(const u32x4*)(st + 4); R.ax1 = *(const u32x4*)(st + 512); R.ac1 = *(const u32x4*)(st + 516); R.uu = *(const u32x4*)(zr + ZD + c0); }
    else { if (t >= 1) { R.ax1 = *(const u32x4*)(zr - NINP + ZAX + c0); R.ac1 = *(const u32x4*)(zr - NINP + ZAC + c0); }
           if (t >= 2) { R.ax2 = *(const u32x4*)(zr - 2 * NINP + ZAX + c0); R.ac2 = *(const u32x4*)(zr - 2 * NINP + ZAC + c0); } }
}
__device__ __forceinline__ void p2_row_compute(CA a, int l, int r, int lane, const RowIn& R) {
    a = fresh_args();
    bf16* MIX = (bf16*)(a->ws + WS_MIX); bf16* VD = (bf16*)(a->ws + WS_VD);
    const int c0 = lane * 8; const bool smp = r >= NPROMPT; const int b = r >> 11, t = r & 2047, s = r - NPROMPT;
    float ax[8], ac[8], ab[8], p0[8], p1[8], p2[8], w0[8], w1[8], w2[8], y[8];
    up8(R.ax, ax); up8(R.ac, ac); up8(R.ab, ab);
#pragma unroll
    for (int e = 0; e < 8; ++e) p0[e] = ac[e] * ax[e];
    if (smp) { p1[0] = __uint_as_float(R.ax1.x); p1[1] = __uint_as_float(R.ax1.y); p1[2] = __uint_as_float(R.ax1.z); p1[3] = __uint_as_float(R.ax1.w); p1[4] = __uint_as_float(R.ac1.x); p1[5] = __uint_as_float(R.ac1.y); p1[6] = __uint_as_float(R.ac1.z); p1[7] = __uint_as_float(R.ac1.w);
               p2[0] = __uint_as_float(R.ax2.x); p2[1] = __uint_as_float(R.ax2.y); p2[2] = __uint_as_float(R.ax2.z); p2[3] = __uint_as_float(R.ax2.w); p2[4] = __uint_as_float(R.ac2.x); p2[5] = __uint_as_float(R.ac2.y); p2[6] = __uint_as_float(R.ac2.z); p2[7] = __uint_as_float(R.ac2.w); }
    else { up8(R.ax1, ax); up8(R.ac1, ac);
#pragma unroll
        for (int e = 0; e < 8; ++e) p1[e] = ac[e] * ax[e];
        up8(R.ax2, ax); up8(R.ac2, ac);
#pragma unroll
        for (int e = 0; e < 8; ++e) p2[e] = ac[e] * ax[e]; }
    ldf8(a->in[I_CAW] + (l * 3 + 0) * 512 + c0, w0); ldf8(a->in[I_CAW] + (l * 3 + 1) * 512 + c0, w1); ldf8(a->in[I_CAW] + (l * 3 + 2) * 512 + c0, w2);
#pragma unroll
    for (int e = 0; e < 8; ++e) y[e] = ab[e] * (w0[e] * p2[e] + w1[e] * p1[e] + w2[e] * p0[e]);
    st8(MIX + (size_t)r * DM + c0, y);
    if (smp) { stf8(a->out + O_CAS + ((size_t)(l * 128 + s) * 2 + 0) * 512 + c0, p1); stf8(a->out + O_CAS + ((size_t)(l * 128 + s) * 2 + 1) * 512 + c0, p0); }
    else if (t >= SEQ - 2) stf8(a->out + O_CAP + ((size_t)(l * 4 + b) * 2 + (t - (SEQ - 2))) * 512 + c0, p0);
    float v[8], g[8], bt[8]; up8(R.vv, v); float sm = 0.f;
#pragma unroll
    for (int e = 0; e < 8; ++e) { v[e] = geluf(v[e]); sm += v[e]; }
    const float mu = wave_sum(sm) * (1.0f / 512.0f); float q = 0.f;
#pragma unroll
    for (int e = 0; e < 8; ++e) { v[e] -= mu; q += v[e] * v[e]; }
    const float rstd = rsqrtf(wave_sum(q) * (1.0f / 512.0f) + EPS);
    ldf8(a->in[I_LNDG] + l * 512 + c0, g); ldf8(a->in[I_LNDB] + l * 512 + c0, bt);
#pragma unroll
    for (int e = 0; e < 8; ++e) v[e] = v[e] * rstd * g[e] + bt[e];
    if (smp) { stf8(a->out + O_SVS + (size_t)(l * 128 + s) * 512 + c0, v);
        const int h = c0 >> 7; const float w00 = a->in[I_SGW][(size_t)(l * 4 + h) * 128 * 128], b00 = a->in[I_SGB][(l * 4 + h) * 128]; float up[8];
        up8(R.uu, up);
#pragma unroll
        for (int e = 0; e < 8; ++e) y[e] = geluf(up[e]) * (w00 * v[e] + b00);
        st8(MIX + (size_t)r * DM + 1536 + c0, y); }
    else { st8(VD + (size_t)r * 512 + c0, v); if (t >= SEQ - 128) stf8(a->out + O_SVP + ((size_t)(l * 4 + b) * 128 + (t - (SEQ - 128))) * 512 + c0, v); }
}

#define XB_TMO      128
#define XB_XCNT(j)  (256  + 64 * (j))
#define XB_XSUB(j)  (1280 + 64 * (j))
#define XB_XGEN(j)  (2304 + 64 * (j))
#define XB_TOP      3328
#define XB_TOPGEN   3392
#define XCD_BAR_WORDS 3456
#define XB_SPIN_CAP (1u << 18)

__device__ __forceinline__ unsigned xb_ld(unsigned* p)              { return __hip_atomic_load(p, __ATOMIC_RELAXED, __HIP_MEMORY_SCOPE_AGENT); }
__device__ __forceinline__ unsigned xb_add(unsigned* p, unsigned v) { return __hip_atomic_fetch_add(p, v, __ATOMIC_RELAXED, __HIP_MEMORY_SCOPE_AGENT); }
__device__ __forceinline__ unsigned xb_xcc_id() { return (unsigned)__builtin_amdgcn_s_getreg((3 << 11) | 20) & 0xFu; }
#define XB_SPIN(cond, bar) do { unsigned _sp = 0; while (cond) { __builtin_amdgcn_s_sleep(1); \
    if ((++_sp & 255u) == 0u) { if (xb_ld(&(bar)[XB_TMO])) break; if (_sp > XB_SPIN_CAP) { atomicAdd(&(bar)[XB_TMO], 1u); break; } } } } while (0)

struct XcdBarrier {
    unsigned* bar; unsigned x;
    volatile LAS unsigned* st;
};

__device__ __forceinline__ XcdBarrier xcd_barrier_post(unsigned* bar, volatile LAS unsigned* st) {
    XcdBarrier b; b.bar = bar; b.x = xb_xcc_id(); b.st = st;
    if (threadIdx.x == 0) (void)xb_add(&bar[XB_XCNT(b.x)], 1u);
    return b;
}
__device__ __forceinline__ void xcd_barrier_complete(unsigned* bar, unsigned x, unsigned& nloc, unsigned& nx) {
    const unsigned G = gridDim.x * gridDim.y * gridDim.z;
    unsigned sum, cnt, mine, sp = 0u;
    for (;;) {
        sum = 0u; cnt = 0u; mine = 0u;
#pragma unroll
        for (unsigned j = 0; j < 16; ++j) { const unsigned c = xb_ld(&bar[XB_XCNT(j)]); sum += c; cnt += (c > 0u) ? 1u : 0u; mine = (j == x) ? c : mine; }
        if (sum == G) break;
        __builtin_amdgcn_s_sleep(1);
        if ((++sp & 255u) == 0u) { if (xb_ld(&bar[XB_TMO])) break; if (sp > XB_SPIN_CAP) { atomicAdd(&bar[XB_TMO], 1u); break; } }
    }
    nloc = mine > 0u ? mine : 1u; nx = cnt > 0u ? cnt : 1u;
}

__device__ __forceinline__ void xcd_barrier(const XcdBarrier& b) {
    asm volatile("s_waitcnt vmcnt(0)" ::: "memory");
    __syncthreads();
    if (threadIdx.x == 0) {
        unsigned* bar = b.bar;
        __builtin_amdgcn_s_waitcnt(0);
        unsigned nloc = b.st[0], nx = b.st[1];
        if (nloc == 0u) { xcd_barrier_complete(bar, b.x, nloc, nx); b.st[0] = nloc; b.st[1] = nx; }
        const unsigned old = xb_add(&bar[XB_XSUB(b.x)], 1u);
        const unsigned gen = old / nloc;
        if (old + 1u == (gen + 1u) * nloc) {
            __builtin_amdgcn_fence(__ATOMIC_RELEASE, "agent");
            asm volatile("s_waitcnt vmcnt(0)" ::: "memory");
            const unsigned og = xb_add(&bar[XB_TOP], 1u);
            const unsigned tg = og / nx;
            if (og + 1u == (tg + 1u) * nx) xb_add(&bar[XB_TOPGEN], 1u);
            else XB_SPIN(xb_ld(&bar[XB_TOPGEN]) == tg, bar);
            __builtin_amdgcn_fence(__ATOMIC_ACQUIRE, "agent");
            xb_add(&bar[XB_XGEN(b.x)], 1u);
            asm volatile("s_waitcnt vmcnt(0)" ::: "memory");
        } else {
            XB_SPIN(xb_ld(&bar[XB_XGEN(b.x)]) == gen, bar);
            __builtin_amdgcn_fence(__ATOMIC_ACQUIRE, "agent");
            asm volatile("s_waitcnt vmcnt(0)" ::: "memory");
        }
    }
    __syncthreads();
}

#ifndef REP_P1
#define REP_P1 1
#endif
#ifndef REP_P6
#define REP_P6 1
#endif
#ifndef REP_GDS
#define REP_GDS 1
#endif
#ifndef REP_CONF
#define REP_CONF 1
#endif
#ifndef REP_WI
#define REP_WI 1
#endif
#ifndef REP_P0
#define REP_P0 1
#endif
#ifndef REP_P2
#define REP_P2 1
#endif
#ifndef REP_P4
#define REP_P4 1
#endif
#define FRESH() int tid = threadIdx.x; asm volatile("" : "+v"(tid)); const int lane = tid & 63, wave = __builtin_amdgcn_readfirstlane(tid >> 6), blk = blockIdx.x, nblk = gridDim.x; CA a = fresh_args(); unsigned char* ws = a->ws; (void)lane; (void)wave; (void)blk; (void)nblk; (void)ws
__global__ void __launch_bounds__(512, 2) mk_fwd(Args kargs) {
    extern __shared__ __attribute__((aligned(16))) unsigned char lds_raw[];
    LAS unsigned char* lds = (LAS unsigned char*)lds_raw;
    cg::grid_group grid = cg::this_grid();
    volatile LAS unsigned* bst = (volatile LAS unsigned*)(lds + LDS_BYTES - 64);
    { FRESH(); if (tid < 16) bst[tid] = 0u; __syncthreads();
      if (a->pad0 == 0x5eed5eed) grid.sync();
      (void)xcd_barrier_post((unsigned*)(ws + WS_BAR), bst); }
#define SEAM() do { CA a_ = fresh_args(); XcdBarrier xb_; xb_.bar = (unsigned*)(a_->ws + WS_BAR); xb_.x = xb_xcc_id(); xb_.st = bst; xcd_barrier(xb_); } while (0)
#pragma unroll 1
    for (int l = 0; l < 2; ++l) {
#ifndef NO_P0
        for (int rep = 0; rep < REP_P0; ++rep) { FRESH(); p0_prologue(a, l, lds, blk * 8 + wave, nblk * 8, wave, lane); }
#endif
        SEAM();
#ifndef NO_P1
        {
            FRESH(); unsigned char* wl = ws + WS_W;
            pg8::Gemm g{(const bf16*)(ws + WS_XB), (const bf16*)(wl + WL_IN), MP, NINP, DM}; pg8::StaticOrder S; S.init(MP, NINP, nblk, blk, DM);
            pg8::EpiZ E{(bf16*)(ws + WS_ZACT), NINP, (const float*)(ws + WS_SSQ) + (2 * l) * MP};
            for (int rep = 0; rep < REP_P1; ++rep) pg8::gemm_phase<pg8::EpiZ, pg8::StaticOrder, true, true>(lds, g, S, E);
        }
#endif
        SEAM();
#ifndef NO_P2
        {
            FRESH();
            for (int it = blk; it < 768; it += nblk) {
                if (it < 512) { for (int rep = 0; rep < REP_GDS; ++rep) p2_gla_ds(a, l, it, lds, tid); }
                else { for (int rep = 0; rep < REP_CONF; ++rep) p2_conf(a, l, it - 512, lds, tid, wave, lane); }
            }
            if (nblk == 256) {
                const int gwv = blk * 8 + wave, g16 = gwv >> 4, w16 = gwv & 15;
                if (w16 < 5) { const int si = g16 * 5 + w16; if (si < 512) p2_gla_sample_w(a, l, si, lane); else p2_conf_sample_w(a, l, si - 512, lane);
                    const int r0 = 7040 + si * 2; RowIn R0, R1; p2_row_load(a, l, r0, lane, R0); p2_row_load(a, l, r0 + 1, lane, R1); p2_row_compute(a, l, r0, lane, R0); p2_row_compute(a, l, r0 + 1, lane, R1); }
                else { const int r0 = (g16 * 11 + (w16 - 5)) * 5;
#pragma unroll 1
                    for (int q = 0; q < 2; ++q) { RowIn R0, R1; p2_row_load(a, l, r0 + 2 * q, lane, R0); p2_row_load(a, l, r0 + 2 * q + 1, lane, R1); p2_row_compute(a, l, r0 + 2 * q, lane, R0); p2_row_compute(a, l, r0 + 2 * q + 1, lane, R1); }
                    { RowIn R0; p2_row_load(a, l, r0 + 4, lane, R0); p2_row_compute(a, l, r0 + 4, lane, R0); } }
            } else {
                for (int wi = blk * 8 + wave; wi < 4160 + 512 + 128; wi += nblk * 8) {
                    if (wi < 4160) { const int r0 = wi * 2; RowIn R0, R1; p2_row_load(a, l, r0, lane, R0); p2_row_load(a, l, r0 + 1, lane, R1); p2_row_compute(a, l, r0, lane, R0); p2_row_compute(a, l, r0 + 1, lane, R1); }
                    else if (wi < 4672) p2_gla_sample_w(a, l, wi - 4160, lane);
                    else p2_conf_sample_w(a, l, wi - 4672, lane);
                }
            }
        }
#endif
        SEAM();
        {
            FRESH();
            for (int gidx = blk * 512 + tid; gidx < 131072; gidx += nblk * 512) {
                const int bh = gidx >> 13, b = bh >> 2, h = bh & 3, e = gidx & 8191, d = e >> 7;
                float* DS = (float*)(ws + WS_DS); const float* dec = (const float*)(ws + WS_DEC); float Sv = 0.f;
                { float dsv[32], dcv[32];
#pragma unroll
                    for (int c = 0; c < 32; ++c) { const int itc = (b * 32 + c) * 4 + h; dsv[c] = DS[(size_t)itc * 8192 + e]; dcv[c] = dec[itc * 64 + d]; }
#pragma unroll
                    for (int c = 0; c < 32; ++c) { const int itc = (b * 32 + c) * 4 + h; __hip_atomic_store((unsigned*)(DS + (size_t)itc * 8192 + e), __float_as_uint(Sv), __ATOMIC_RELAXED, __HIP_MEMORY_SCOPE_AGENT); Sv = dcv[c] * Sv + dsv[c]; } }
                a->out[O_GP + (size_t)((l * 4 + b) * 4 + h) * 8192 + e] = Sv;
                asm volatile("s_waitcnt vmcnt(0)" ::: "memory");
                if (lane == 0) __hip_atomic_fetch_add((unsigned*)(ws + WS_CNT) + 256 + (l * 16 + bh) * 16, 1u, __ATOMIC_RELAXED, __HIP_MEMORY_SCOPE_AGENT);
            }
        }
#ifndef NO_P4
        {
            FRESH();
            for (int it = 512 + blk; it < 768; it += nblk) p4_sgu(a, l, it - 512, lds, tid);
            for (int it = blk; it < 512; it += nblk) {
                if (tid < 64) { const unsigned* cw = (const unsigned*)(ws + WS_CNT) + 256 + (l * 16 + (it >> 7) * 4 + (it & 3)) * 16; unsigned sp = 0;
                    while ((unsigned)__builtin_amdgcn_readfirstlane((int)__hip_atomic_load(cw, __ATOMIC_RELAXED, __HIP_MEMORY_SCOPE_AGENT)) < 128u) { __builtin_amdgcn_s_sleep(1); if (++sp > (1u << 20)) break; }
                    __builtin_amdgcn_fence(__ATOMIC_ACQUIRE, "agent"); asm volatile("s_waitcnt vmcnt(0)" ::: "memory"); }
                p4_gla_o(a, l, it, lds, tid);
            }
        }
#endif
        SEAM();
#ifndef NO_P5
        {
            FRESH(); unsigned char* wl = ws + WS_W;
            pg8::Gemm g{(const bf16*)(ws + WS_MIX), (const bf16*)(wl + WL_O), MP, DM, DM}; pg8::SplitOrder S; S.init(DM, nblk, blk, DM, 8);
            pg8::EpiRes<8> E{a->out + O_Y, (bf16*)(ws + WS_XB), (float*)(ws + WS_SSQ) + (2 * l + 1) * MP, (unsigned*)(ws + WS_CNT) + (2 * l) * 64, 8, (float*)(ws + WS_PART)};
            pg8::gemm_phase<pg8::EpiRes<8>, pg8::SplitOrder, true, true>(lds, g, S, E);
        }
#endif
        SEAM();
#ifndef NO_P6
        {
            FRESH(); unsigned char* wl = ws + WS_W;
            pg8::Gemm g{(const bf16*)(ws + WS_XB), (const bf16*)(wl + WL_GU), MP, 2 * DFF, DM}; pg8::StaticOrder S; S.init(MP, 2 * DFF, nblk, blk, DM);
            pg8::EpiGU E{(bf16*)(ws + WS_ZACT), DFF, (const float*)(ws + WS_SSQ) + (2 * l + 1) * MP};
            for (int rep = 0; rep < REP_P6; ++rep) pg8::gemm_phase<pg8::EpiGU, pg8::StaticOrder, true, true>(lds, g, S, E);
        }
#endif
        SEAM();
#ifndef NO_P7
        {
            FRESH(); unsigned char* wl = ws + WS_W;
            pg8::Gemm g{(const bf16*)(ws + WS_ZACT), (const bf16*)(wl + (l ? WL_D1 : WL_D)), MP, DM, DFF}; pg8::SplitOrder S; S.init(DM, nblk, blk, DFF, 11);
            pg8::EpiRes<11> E{a->out + O_Y, (bf16*)(ws + WS_XB), (float*)(ws + WS_SSQ) + (2 * l + 2) * MP, (unsigned*)(ws + WS_CNT) + (2 * l + 1) * 64, 11, (float*)(ws + WS_PART)};
            pg8::gemm_phase<pg8::EpiRes<11>, pg8::SplitOrder, true, true>(lds, g, S, E);
        }
#endif
        if (l == 1) SEAM();
    }
#ifdef EXTRA_SYNCS
    for (int q = 0; q < EXTRA_SYNCS; ++q) SEAM();
#endif
    {
        FRESH(); float* Y = a->out + O_Y; const bf16* XB = (const bf16*)(ws + WS_XB);
        for (int r0 = (blk * 8 + wave) * 2; r0 < MR; r0 += nblk * 16) {
            f32x4 v[2][8];
#pragma unroll
            for (int q = 0; q < 2; ++q) { const int r = r0 + q;
                if (r < NPROMPT) {
#pragma unroll
                    for (int j = 0; j < 8; ++j) { float t[4]; ld4(XB + (size_t)r * DM + 256 * j + 4 * lane, t); v[q][j] = (f32x4){t[0], t[1], t[2], t[3]}; }
                } else {
#pragma unroll
                    for (int j = 0; j < 8; ++j) v[q][j] = *(const f32x4*)(Y + (size_t)r * DM + 256 * j + 4 * lane);
                } }
            f32x4 gn[8];
#pragma unroll
            for (int j = 0; j < 8; ++j) gn[j] = *(const f32x4*)(a->in[I_NFIN] + 256 * j + 4 * lane);
#pragma unroll
            for (int q = 0; q < 2; ++q) { const int r = r0 + q; float ss = 0.f;
#pragma unroll
                for (int j = 0; j < 8; ++j) ss += (v[q][j][0] * v[q][j][0] + v[q][j][1] * v[q][j][1]) + (v[q][j][2] * v[q][j][2] + v[q][j][3] * v[q][j][3]);
                const float rs = rsqrtf(wave_sum(ss) * (1.0f / 2048.0f) + EPS);
#pragma unroll
                for (int j = 0; j < 8; ++j) *(f32x4*)(Y + (size_t)r * DM + 256 * j + 4 * lane) = v[q][j] * rs * gn[j]; }
        }
    }
}

extern "C" void kernel_launch(void* const* d_in, const int* in_sizes, int n_in, void* d_out, int out_size, void* d_ws, size_t ws_size, hipStream_t stream) {
    static int grid = 0;
    if (grid == 0) {
        int dev = 0, cus = 0, per_cu = 0;
        if (n_in != 25 || out_size != 30670848 || ws_size < WS_END) { fprintf(stderr, "kernel_launch: unexpected shapes (n_in %d out %d ws %zu, need %zu)\n", n_in, out_size, ws_size, (size_t)WS_END); grid = -1; return; }
        (void)hipGetDevice(&dev);
        (void)hipDeviceGetAttribute(&cus, hipDeviceAttributeMultiprocessorCount, dev);
        (void)hipFuncSetAttribute((const void*)mk_fwd, hipFuncAttributeMaxDynamicSharedMemorySize, LDS_BYTES);
        (void)hipOccupancyMaxActiveBlocksPerMultiprocessor(&per_cu, (const void*)mk_fwd, 512, LDS_BYTES);
        if (per_cu < 1) { fprintf(stderr, "kernel_launch: occupancy query reports %d blocks per CU\n", per_cu); grid = -1; return; }
        grid = cus;
    }
    if (grid < 0) return;
    (void)hipMemsetAsync((unsigned char*)d_ws + WS_BAR, 0, 256 * 1024, stream);
    Args ha{};
    for (int i = 0; i < 25; ++i) ha.in[i] = (const float*)d_in[i];
    ha.out = (float*)d_out; ha.ws = (unsigned char*)d_ws; ha.pad0 = 0; ha.pad1 = 0;
    void* args[] = {&ha};
    hipError_t e = hipLaunchCooperativeKernel((void*)mk_fwd, dim3(grid), dim3(512), args, LDS_BYTES, stream);
    if (e != hipSuccess) fprintf(stderr, "cooperative launch failed: %s (grid %d)\n", hipGetErrorString(e), grid);
}
```

```cpp
#include <hip/hip_runtime.h>
#include <hip/hip_cooperative_groups.h>
#include <cstdio>
#include <cstdint>
namespace cg = cooperative_groups;

constexpr int DM = 2048, NPROMPT = 8192, MR = 8320, MP = 8448, NIN = 5136, NINP = 5376, DFF = 5632, SEQ = 2048;
constexpr int ZAX = 0, ZAB = 512, ZAC = 1024, ZQ = 1536, ZK = 1792, ZV = 2048, ZR = 2560, ZLR = 3072, ZC = 3088, ZD = 4112;
constexpr float EPS = 1e-6f;

namespace pg8 {
#define PG8_LAS __attribute__((address_space(3)))
typedef unsigned short bf16_t;
typedef short bf16x8 __attribute__((ext_vector_type(8)));
typedef float f32x4 __attribute__((ext_vector_type(4)));
typedef unsigned u32x4 __attribute__((ext_vector_type(4)));
constexpr int BM = 256, BK = 64, HALF = 128, HTB = HALF * BK * 2  , STAGE_BYTES = 8 * HTB, NXCD = 8, WGM = 4;

__host__ __device__ __forceinline__ int lds_byte(int r, int c) { const int st = (r >> 4) * 2 + (c >> 5), rr = r & 15, cc = c & 31, ob = rr * 64 + cc * 2; return st * 1024 + (ob ^ (((ob >> 9) & 1) << 5)); }
__host__ __device__ __forceinline__ void stage_rc(int b, int& R, int& C) { const int st = b / 1024, sb = b % 1024, swz = sb ^ (((sb >> 9) & 1) << 5); R = (st >> 1) * 16 + swz / 64; C = (st & 1) * 32 + (swz % 64) / 2; }
__host__ __device__ __forceinline__ int perm32(int rho) { const int n = rho >> 4, i = rho & 15; return 8 * (i >> 2) + 4 * n + (i & 3); }

struct Unit { int pm, pn, k0, nt, kind; };
struct Gemm { const bf16_t* A; const bf16_t* Bt; int M, N, K; };

struct StaticOrder {
    int nM, nN, nwg, G, c, ntk;
    __host__ __device__ void init(int M, int N, int G_, int c_, int K) { nM = M / BM; nN = N / BM; nwg = nM * nN; G = G_; c = c_; ntk = K / BK; }
    __host__ __device__ bool next(int i, Unit& u) const {
        const long L = (long)i * G + c; if (L >= nwg) return false;
        return at((int)L, u); }
    __host__ __device__ bool at(int wgid, Unit& u) const { { const int q = nwg / NXCD, r = nwg % NXCD, xcd = wgid % NXCD, off = wgid / NXCD; wgid = (xcd < r ? xcd * (q + 1) : r * (q + 1) + (xcd - r) * q) + off; }
        const int nig = WGM * nN, gid = wgid / nig, fm = gid * WGM, gsz = (nM - fm) < WGM ? (nM - fm) : WGM;
        u.pm = fm + ((wgid % nig) % gsz); u.pn = (wgid % nig) / gsz; u.k0 = 0; u.nt = ntk; u.kind = 0; return true;
    }
    __device__ __forceinline__ void a_ready(const Unit&) const {}
    __device__ __forceinline__ void done(const Unit&) const {}
};
struct SplitOrder {
    StaticOrder so; int np, parts, ntp, nsub;
    __host__ __device__ void init(int N, int G_, int c_, int K, int parts_) { so.init(8192, N, G_, c_, K); np = so.nwg; parts = parts_; ntp = K / BK / parts_; nsub = so.nN * parts_; }
    __host__ __device__ bool next(int i, Unit& u) const {
        const long L = (long)i * so.G + so.c; if (L < np) return so.at((int)L, u);
        const int j = (int)(L - np); if (j >= nsub) return false;
        u.pm = 32; u.pn = j % so.nN; u.k0 = (j / so.nN) * ntp * BK; u.nt = ntp; u.kind = 1; return true;
    }
    __device__ __forceinline__ void a_ready(const Unit&) const {}
    __device__ __forceinline__ void done(const Unit&) const {}
};
__device__ __forceinline__ unsigned cvt_pk_bf16(float lo, float hi) { unsigned r; asm volatile("v_cvt_pk_bf16_f32 %0, %1, %2" : "=v"(r) : "v"(lo), "v"(hi)); return r; }
typedef float f32x2 __attribute__((ext_vector_type(2)));


typedef unsigned u32x2 __attribute__((ext_vector_type(2)));
struct EpiZ {
    static constexpr bool PERM = true, AFTER_DRAIN = false;
    bf16_t* Z; int ldz; const float* ssq;
    __device__ __forceinline__ void operator()(const f32x4 (&acc)[2][2][4][2], const Unit& u, int wr, int wc, int fr, int fq) const {
        const int row0 = u.pm * BM + wr * 64 + fr, col0 = u.pn * BM + wc * 32 + 8 * fq;
#pragma unroll
        for (int ai = 0; ai < 2; ++ai)
#pragma unroll
            for (int m = 0; m < 4; ++m) { const int r = row0 + ai * HALF + m * 16; const float rs = rsqrtf(ssq[r] * (1.0f / 2048.0f) + 1e-6f);
                bf16_t* rowp = Z + (size_t)r * ldz + col0;
#pragma unroll
                for (int bj = 0; bj < 2; ++bj) { const f32x4 v0 = acc[ai][bj][m][0] * rs, v1 = acc[ai][bj][m][1] * rs;
                    u32x4 w; w.x = cvt_pk_bf16(v0[0], v0[1]); w.y = cvt_pk_bf16(v0[2], v0[3]); w.z = cvt_pk_bf16(v1[0], v1[1]); w.w = cvt_pk_bf16(v1[2], v1[3]);
                    *(u32x4*)(rowp + bj * HALF) = w; } }
    }
};
struct EpiGU {
    static constexpr bool PERM = true, AFTER_DRAIN = false;
    bf16_t* ACT; int lda; const float* ssq;
    __device__ __forceinline__ void operator()(const f32x4 (&acc)[2][2][4][2], const Unit& u, int wr, int wc, int fr, int fq) const {
        const int row0 = u.pm * BM + wr * 64 + fr, j0 = u.pn * HALF + wc * 32 + 8 * fq;
#pragma unroll
        for (int ai = 0; ai < 2; ++ai)
#pragma unroll
            for (int m = 0; m < 4; ++m) { const int r = row0 + ai * HALF + m * 16; const float rs = rsqrtf(ssq[r] * (1.0f / 2048.0f) + 1e-6f);
                float o[8];
#pragma unroll
                for (int n = 0; n < 2; ++n)
#pragma unroll
                    for (int e = 0; e < 4; ++e) { const float g = acc[ai][0][m][n][e] * rs, uu = acc[ai][1][m][n][e] * rs; o[n * 4 + e] = g * __builtin_amdgcn_rcpf(1.0f + __expf(-g)) * uu; }
                u32x4 w; w.x = cvt_pk_bf16(o[0], o[1]); w.y = cvt_pk_bf16(o[2], o[3]); w.z = cvt_pk_bf16(o[4], o[5]); w.w = cvt_pk_bf16(o[6], o[7]);
                *(u32x4*)(ACT + (size_t)r * lda + j0) = w; }
    }
};
template <int PARTS> struct EpiRes {
    static constexpr bool PERM = false, AFTER_DRAIN = false;
    float* X; bf16_t* XB; float* ssq; unsigned* cnt; int parts; float* part;
    __device__ __forceinline__ void operator()(const f32x4 (&acc)[2][2][4][2], const Unit& u, int wr, int wc, int fr, int fq) const {
        if (u.kind == 0) {
            const int row0 = u.pm * BM + wr * 64 + fr, col0 = u.pn * BM + wc * 32 + 4 * fq;
#pragma unroll
            for (int ai = 0; ai < 2; ++ai)
#pragma unroll
                for (int m = 0; m < 4; ++m) { const int r = row0 + ai * HALF + m * 16; float ss = 0.f;
                    bf16_t* xb = XB + (size_t)r * 2048 + col0;
#pragma unroll
                    for (int bj = 0; bj < 2; ++bj)
#pragma unroll
                        for (int n = 0; n < 2; ++n) { const u32x2 xo = *(const u32x2*)(xb + bj * HALF + n * 16);
                            const f32x4 o = (f32x4){__uint_as_float(xo.x << 16), __uint_as_float(xo.x & 0xffff0000u), __uint_as_float(xo.y << 16), __uint_as_float(xo.y & 0xffff0000u)} + acc[ai][bj][m][n];
                            u32x2 w; w.x = cvt_pk_bf16(o[0], o[1]); w.y = cvt_pk_bf16(o[2], o[3]); *(u32x2*)(xb + bj * HALF + n * 16) = w;
                            ss += (o[0] * o[0] + o[1] * o[1]) + (o[2] * o[2] + o[3] * o[3]); }
                    ss += __shfl_xor(ss, 16); ss += __shfl_xor(ss, 32);
                    if (fq == 0) unsafeAtomicAdd(ssq + r, ss);
                    if (m == 3) asm volatile("" ::: "memory"); }
        } else {
            const int kp = u.k0 / (u.nt * BK); float* P = part + (size_t)kp * 128 * 2048;
            const int rl0 = wr * 64 + fr, col0 = u.pn * BM + wc * 32 + 4 * fq;
#pragma unroll
            for (int m = 0; m < 4; ++m) { float* pr = P + (size_t)(rl0 + m * 16) * 2048 + col0;
#pragma unroll
                for (int bj = 0; bj < 2; ++bj)
#pragma unroll
                    for (int n = 0; n < 2; ++n) { const f32x4 v = acc[0][bj][m][n]; float* q = pr + bj * HALF + n * 16;
                        asm volatile("global_store_dwordx4 %0, %1, off sc1" :: "v"(q), "v"(v) : "memory"); } }
            asm volatile("s_waitcnt vmcnt(0)" ::: "memory");
            const int lane = (int)(threadIdx.x & 63);
            unsigned old = 0u;
            if (lane == 0) old = __hip_atomic_fetch_add(cnt + (u.pn * 8 + wr * 4 + wc), 1u, __ATOMIC_RELAXED, __HIP_MEMORY_SCOPE_AGENT);
            old = (unsigned)__builtin_amdgcn_readfirstlane((int)old);
            if (old == (unsigned)(parts - 1)) {
                __builtin_amdgcn_fence(__ATOMIC_ACQUIRE, "agent"); asm volatile("s_waitcnt vmcnt(0)" ::: "memory");
                const int c4 = (lane & 7) * 4, rg = lane >> 3;
                constexpr int NS = PARTS > 6 ? 1 : 2;
#pragma unroll 1
                for (int rs = 0; rs < 8; ++rs) { const int rl = wr * 64 + rs * 8 + rg; float ss = 0.f;
#pragma unroll 1
                    for (int b0 = 0; b0 < 2; b0 += NS) { f32x4 pv[NS][PARTS + 1];
#pragma unroll
                        for (int bb = 0; bb < NS; ++bb) { const size_t co = (size_t)u.pn * BM + (b0 + bb) * HALF + wc * 32 + c4;
                            pv[bb][PARTS] = *(const f32x4*)(X + (size_t)(8192 + rl) * 2048 + co);
#pragma unroll
                            for (int k = 0; k < PARTS; ++k) pv[bb][k] = *(const f32x4*)(part + ((size_t)k * 128 + rl) * 2048 + co); }
#pragma unroll
                        for (int bb = 0; bb < NS; ++bb) { const size_t xo = (size_t)(8192 + rl) * 2048 + (size_t)u.pn * BM + (b0 + bb) * HALF + wc * 32 + c4; f32x4 o = pv[bb][PARTS];
#pragma unroll
                            for (int k = 0; k < PARTS; ++k) o += pv[bb][k];
                            *(f32x4*)(X + xo) = o; u32x2 w; w.x = cvt_pk_bf16(o[0], o[1]); w.y = cvt_pk_bf16(o[2], o[3]); *(u32x2*)(XB + xo) = w;
                            ss += (o[0] * o[0] + o[1] * o[1]) + (o[2] * o[2] + o[3] * o[3]); } }
                    ss += __shfl_xor(ss, 1); ss += __shfl_xor(ss, 2); ss += __shfl_xor(ss, 4);
                    if ((lane & 7) == 0) unsafeAtomicAdd(ssq + 8192 + rl, ss); }
            }
        }
    }
};

template <class Epi, class Sched, bool ALIGN_EPI = false, bool SP2 = false>
__device__ __forceinline__ void gemm_phase(PG8_LAS unsigned char* lds, const Gemm g, const Sched& S, const Epi& E) {
    int tid_ = threadIdx.x; asm volatile("" : "+v"(tid_));
    const int tid = tid_, wid = __builtin_amdgcn_readfirstlane(tid >> 6), lane = tid & 63, wr = wid >> 2, wc = wid & 3, fr = lane & 15, fq = lane >> 4;
    const int K = g.K;
    unsigned voffA[2], voffB[2];
#pragma unroll
    for (int i = 0; i < 2; ++i) { int R, C; stage_rc(tid * 16 + i * 8192, R, C); const int Rb = Epi::PERM ? ((R & ~31) + perm32(R & 31)) : R;
        voffA[i] = (unsigned)(R * K + C) * 2u; voffB[i] = (unsigned)(Rb * K + C) * 2u; }
    const size_t kstep = (size_t)(BK * 2);
    const size_t hstep = (size_t)HALF * K * 2;
    const size_t tstep = 2 * hstep;
    const unsigned ldsw = (unsigned)wid * 1024u;
    const int aoff = lds_byte(wr * 64 + fr, fq * 8), boff = lds_byte(wc * 32 + fr, fq * 8);
#define PG8_SA(b, h) (((b) * 2 + (h)) * HTB)
#define PG8_SB(b, h) ((4 + (b) * 2 + (h)) * HTB)
#define PG8_STAGE(bufoff, gbase, voff) do { _Pragma("unroll") for (int _i = 0; _i < 2; ++_i) \
        __builtin_amdgcn_global_load_lds((const unsigned*)((const char*)(gbase) + (voff)[_i]), (PG8_LAS unsigned*)(lds + (bufoff) + ldsw + _i * 8192), 16, 0, 0); } while (0)
#define PG8_LDA(dst, b, h) do { _Pragma("unroll") for (int m = 0; m < 4; ++m) _Pragma("unroll") for (int k = 0; k < 2; ++k) dst[m][k] = *(const PG8_LAS bf16x8*)(lds + PG8_SA(b, h) + aoff + m * 2048 + k * 1024); } while (0)
#define PG8_LDB(dst, b, h) do { _Pragma("unroll") for (int n = 0; n < 2; ++n) _Pragma("unroll") for (int k = 0; k < 2; ++k) dst[n][k] = *(const PG8_LAS bf16x8*)(lds + PG8_SB(b, h) + boff + n * 2048 + k * 1024); } while (0)
#define PG8_MMA(ai, bj, At, Bt) do { __builtin_amdgcn_s_setprio(1); _Pragma("unroll") for (int m = 0; m < 4; ++m) _Pragma("unroll") for (int n = 0; n < 2; ++n) _Pragma("unroll") for (int k = 0; k < 2; ++k) \
        acc[ai][bj][m][n] = __builtin_amdgcn_mfma_f32_16x16x32_bf16(Bt[n][k], At[m][k], acc[ai][bj][m][n], 0, 0, 0); __builtin_amdgcn_s_setprio(0); } while (0)
#define PG8_WAIT_V(n) asm volatile("s_waitcnt vmcnt(" #n ")" ::: "memory")
#define PG8_WAIT_L(n) asm volatile("s_waitcnt lgkmcnt(" #n ")" ::: "memory")
#define PG8_BAR __builtin_amdgcn_s_barrier()
#define PG8_SCHED __builtin_amdgcn_sched_barrier(0)
    Unit cur, nxt; int ui = 0;
    if (!S.next(0, cur)) return;
    f32x4 acc[2][2][4][2];
#pragma unroll
    for (int a = 0; a < 2; ++a)
#pragma unroll
        for (int b = 0; b < 2; ++b)
#pragma unroll
            for (int m = 0; m < 4; ++m)
#pragma unroll
                for (int n = 0; n < 2; ++n) acc[a][b][m][n] = (f32x4){0.f, 0.f, 0.f, 0.f};
    bf16x8 At[4][2], B0[2][2], B1[2][2];
    const char* cA = (const char*)g.A + (size_t)cur.pm * tstep + (size_t)cur.k0 * 2; const char* cB = (const char*)g.Bt + (size_t)cur.pn * tstep + (size_t)cur.k0 * 2;
    S.a_ready(cur);
    if constexpr (SP2) {
        PG8_STAGE(PG8_SB(0, 0), cB, voffB); PG8_STAGE(PG8_SB(0, 1), cB + hstep, voffB); PG8_STAGE(PG8_SA(0, 0), cA, voffA); PG8_STAGE(PG8_SA(0, 1), cA + hstep, voffA);
        if (wr == 1) PG8_BAR;
        PG8_WAIT_V(2); PG8_BAR;
        PG8_STAGE(PG8_SB(1, 0), cB + kstep, voffB); PG8_STAGE(PG8_SA(1, 0), cA + kstep, voffA); PG8_STAGE(PG8_SB(1, 1), cB + hstep + kstep, voffB);
        PG8_WAIT_V(6); PG8_BAR;
    } else {
        PG8_STAGE(PG8_SB(0, 0), cB, voffB); PG8_STAGE(PG8_SA(0, 0), cA, voffA); PG8_STAGE(PG8_SB(0, 1), cB + hstep, voffB); PG8_STAGE(PG8_SA(0, 1), cA + hstep, voffA);
        if (wr == 1) PG8_BAR;
        PG8_WAIT_V(4); PG8_BAR;
        PG8_STAGE(PG8_SB(1, 0), cB + kstep, voffB); PG8_STAGE(PG8_SA(1, 0), cA + kstep, voffA); PG8_STAGE(PG8_SB(1, 1), cB + hstep + kstep, voffB);
        PG8_WAIT_V(6); PG8_BAR;
    }
    for (;;) {
        const bool has_next = S.next(ui + 1, nxt);
        const char* nA = has_next ? (const char*)g.A + (size_t)nxt.pm * tstep + (size_t)nxt.k0 * 2 : cA; const char* nB = has_next ? (const char*)g.Bt + (size_t)nxt.pn * tstep + (size_t)nxt.k0 * 2 : cB;
        const int nt = cur.nt;
        for (int t = 0; t < nt; t += 2) {
            const bool last = (t == nt - 2);
            const char* a1 = cA + (size_t)(t + 1) * kstep;
            const char* a2 = last ? nA : cA + (size_t)(t + 2) * kstep; const char* b2 = last ? nB : cB + (size_t)(t + 2) * kstep;
            const char* a3 = a2 + kstep; const char* b3 = b2 + kstep;
            if (last && has_next) S.a_ready(nxt);
            if constexpr (SP2) {
            PG8_LDB(B0, 0, 0); PG8_LDB(B1, 0, 1); PG8_SCHED; PG8_LDA(At, 0, 0); PG8_STAGE(PG8_SA(1, 1), a1 + hstep, voffA);
            PG8_WAIT_V(8); PG8_WAIT_L(0); PG8_BAR; PG8_MMA(0, 0, At, B0); PG8_MMA(0, 1, At, B1); PG8_BAR; PG8_SCHED;
            PG8_LDA(At, 0, 1); PG8_STAGE(PG8_SB(0, 0), b2, voffB); PG8_STAGE(PG8_SB(0, 1), b2 + hstep, voffB); PG8_STAGE(PG8_SA(0, 0), a2, voffA);
            PG8_WAIT_V(8); PG8_WAIT_L(0); PG8_BAR; PG8_MMA(1, 0, At, B0); PG8_MMA(1, 1, At, B1); PG8_BAR; PG8_SCHED;
            PG8_LDB(B0, 1, 0); PG8_LDB(B1, 1, 1); PG8_SCHED; PG8_LDA(At, 1, 0); PG8_STAGE(PG8_SA(0, 1), a2 + hstep, voffA);
            PG8_WAIT_V(8); PG8_WAIT_L(0); PG8_BAR; PG8_MMA(0, 0, At, B0); PG8_MMA(0, 1, At, B1); PG8_BAR; PG8_SCHED;
            PG8_LDA(At, 1, 1); PG8_STAGE(PG8_SB(1, 0), b3, voffB); PG8_STAGE(PG8_SB(1, 1), b3 + hstep, voffB); PG8_STAGE(PG8_SA(1, 0), a3, voffA);
            PG8_WAIT_V(8); PG8_WAIT_L(0); PG8_BAR; PG8_MMA(1, 0, At, B0); PG8_MMA(1, 1, At, B1); PG8_BAR; PG8_SCHED;
            } else {
            PG8_LDB(B0, 0, 0); PG8_SCHED; PG8_LDA(At, 0, 0); PG8_STAGE(PG8_SA(1, 1), a1 + hstep, voffA);
            PG8_WAIT_L(8); PG8_BAR; PG8_WAIT_L(0); PG8_MMA(0, 0, At, B0); PG8_BAR; PG8_SCHED;
            PG8_LDB(B1, 0, 1); PG8_STAGE(PG8_SB(0, 0), b2, voffB);
            PG8_BAR; PG8_WAIT_L(0); PG8_MMA(0, 1, At, B1); PG8_BAR;
            PG8_LDA(At, 0, 1); PG8_STAGE(PG8_SA(0, 0), a2, voffA);
            PG8_BAR; PG8_WAIT_L(0); PG8_MMA(1, 0, At, B0); PG8_BAR; PG8_SCHED;
            PG8_STAGE(PG8_SB(0, 1), b2 + hstep, voffB);
            PG8_WAIT_V(6); PG8_BAR; PG8_MMA(1, 1, At, B1); PG8_BAR;
            PG8_LDB(B0, 1, 0); PG8_SCHED; PG8_LDA(At, 1, 0); PG8_STAGE(PG8_SA(0, 1), a2 + hstep, voffA);
            PG8_WAIT_L(8); PG8_BAR; PG8_WAIT_L(0); PG8_MMA(0, 0, At, B0); PG8_BAR; PG8_SCHED;
            PG8_LDB(B1, 1, 1); PG8_STAGE(PG8_SB(1, 0), b3, voffB);
            PG8_BAR; PG8_WAIT_L(0); PG8_MMA(0, 1, At, B1); PG8_BAR;
            PG8_LDA(At, 1, 1); PG8_STAGE(PG8_SA(1, 0), a3, voffA);
            PG8_BAR; PG8_WAIT_L(0); PG8_MMA(1, 0, At, B0); PG8_BAR; PG8_SCHED;
            PG8_STAGE(PG8_SB(1, 1), b3 + hstep, voffB);
            PG8_WAIT_V(6); PG8_BAR; PG8_MMA(1, 1, At, B1); PG8_BAR;
            }
        }
        if constexpr (ALIGN_EPI) { if (wr == 0) PG8_BAR; }
        if constexpr (!Epi::AFTER_DRAIN) { E(acc, cur, wr, wc, fr, fq); S.done(cur); }
        if (!has_next) break;
#pragma unroll
        for (int a = 0; a < 2; ++a)
#pragma unroll
            for (int b = 0; b < 2; ++b)
#pragma unroll
                for (int m = 0; m < 4; ++m)
#pragma unroll
                    for (int n = 0; n < 2; ++n) acc[a][b][m][n] = (f32x4){0.f, 0.f, 0.f, 0.f};
        cur = nxt; cA = nA; cB = nB; ++ui;
        if constexpr (ALIGN_EPI) { if (wr == 1) PG8_BAR; }
    }
    PG8_WAIT_V(0);
    if constexpr (!ALIGN_EPI) { if (wr == 0) PG8_BAR; }
    PG8_BAR;
    if constexpr (Epi::AFTER_DRAIN) { E.fused(acc, cur, wr, wc, fr, fq, lds, wid, lane); S.done(cur); }
#undef PG8_SA
#undef PG8_SB
#undef PG8_STAGE
#undef PG8_LDA
#undef PG8_LDB
#undef PG8_MMA
#undef PG8_WAIT_V
#undef PG8_WAIT_L
#undef PG8_BAR
#undef PG8_SCHED
}
}


#define LAS __attribute__((address_space(3)))
typedef unsigned short bf16;
typedef float f32x4 __attribute__((ext_vector_type(4)));
typedef float f32x2 __attribute__((ext_vector_type(2)));
typedef unsigned u32x4 __attribute__((ext_vector_type(4)));
typedef unsigned u32x2 __attribute__((ext_vector_type(2)));
constexpr int LDS_BYTES = 147456;
constexpr size_t MiB = 1u << 20;
constexpr size_t WS_SSQ = 0, WS_DEC = 256 * 1024, WS_BAR = 512 * 1024, WS_CNT = 640 * 1024, WS_XB = 1 * MiB, WS_MIX = 34 * MiB, WS_ZACT = 67 * MiB, WS_DS = 158 * MiB, WS_VD = 174 * MiB, WS_W = 182 * MiB;
constexpr size_t WL_IN = 0, WL_O = 21 * MiB, WL_GU = 29 * MiB, WL_D = 73 * MiB, WL_BYTES = 95 * MiB, WL_D1 = 95 * MiB, WS_PART = WS_W + WL_BYTES + 22 * MiB, WS_END = WS_PART + 12 * MiB;
static_assert((size_t)MP * DM * 2 <= 33 * MiB && (size_t)MP * DFF * 2 <= 91 * MiB && (size_t)NINP * DM * 2 <= 21 * MiB && (size_t)2 * DFF * DM * 2 <= 44 * MiB && (size_t)DM * DFF * 2 <= 22 * MiB, "ws map");
constexpr size_t O_Y = 0, O_CAP = 17039360, O_CAS = 17047552, O_GP = 17309696, O_GS = 17571840, O_CCP = 25960448, O_CCS = 26083328, O_SVP = 30015488, O_SVS = 30539776;
enum { I_XP = 0, I_XS, I_SCA, I_SGLA, I_SCC, I_NMIX, I_WIN, I_CAW, I_A2, I_ABIAS, I_GNORM, I_CCW, I_CCB, I_LNCG, I_LNCB, I_LNDG, I_LNDB, I_SGW, I_SGB, I_WO, I_NFFN, I_WG, I_WU, I_WD, I_NFIN };
struct Args { const float* in[25]; float* out; unsigned char* ws; int pad0, pad1; };
typedef const __attribute__((address_space(4))) Args* CA;
__device__ __forceinline__ CA fresh_args() { CA p = (CA)__builtin_amdgcn_kernarg_segment_ptr(); asm volatile("" : "+s"(p)); return p; }

__device__ __forceinline__ float bflo(unsigned w) { return __uint_as_float(w << 16); }
__device__ __forceinline__ float bfhi(unsigned w) { return __uint_as_float(w & 0xffff0000u); }
__device__ __forceinline__ float bf2f(bf16 v) { return __uint_as_float((unsigned)v << 16); }
__device__ __forceinline__ unsigned pk2(float lo, float hi) { return pg8::cvt_pk_bf16(lo, hi); }
__device__ __forceinline__ void ld8(const bf16* p, float (&v)[8]) { const u32x4 w = *(const u32x4*)p; v[0] = bflo(w.x); v[1] = bfhi(w.x); v[2] = bflo(w.y); v[3] = bfhi(w.y); v[4] = bflo(w.z); v[5] = bfhi(w.z); v[6] = bflo(w.w); v[7] = bfhi(w.w); }
__device__ __forceinline__ void up8(const u32x4 w, float (&v)[8]) { v[0] = bflo(w.x); v[1] = bfhi(w.x); v[2] = bflo(w.y); v[3] = bfhi(w.y); v[4] = bflo(w.z); v[5] = bfhi(w.z); v[6] = bflo(w.w); v[7] = bfhi(w.w); }
__device__ __forceinline__ void ld4(const bf16* p, float (&v)[4]) { const u32x2 w = *(const u32x2*)p; v[0] = bflo(w.x); v[1] = bfhi(w.x); v[2] = bflo(w.y); v[3] = bfhi(w.y); }
__device__ __forceinline__ void st8(bf16* p, const float (&v)[8]) { u32x4 w; w.x = pk2(v[0], v[1]); w.y = pk2(v[2], v[3]); w.z = pk2(v[4], v[5]); w.w = pk2(v[6], v[7]); *(u32x4*)p = w; }
__device__ __forceinline__ void ldf8(const float* p, float (&v)[8]) { const f32x4 a = *(const f32x4*)p, b = *(const f32x4*)(p + 4); v[0] = a[0]; v[1] = a[1]; v[2] = a[2]; v[3] = a[3]; v[4] = b[0]; v[5] = b[1]; v[6] = b[2]; v[7] = b[3]; }
__device__ __forceinline__ void stf8(float* p, const float (&v)[8]) { *(f32x4*)p = (f32x4){v[0], v[1], v[2], v[3]}; *(f32x4*)(p + 4) = (f32x4){v[4], v[5], v[6], v[7]}; }
__device__ __forceinline__ float wave_sum(float v) {
#pragma unroll
    for (int o = 1; o < 64; o <<= 1) v += __shfl_xor(v, o);
    return v; }
__device__ __forceinline__ float sigmf(float x) { return __builtin_amdgcn_rcpf(1.0f + __expf(-x)); }
__device__ __forceinline__ float siluf(float x) { return x * __builtin_amdgcn_rcpf(1.0f + __expf(-x)); }
__device__ __forceinline__ float geluf(float x) { const float y = 0.7978845608028654f * (x + 0.044715f * x * x * x); const float t = 1.0f - 2.0f * __builtin_amdgcn_rcpf(__expf(2.0f * y) + 1.0f); return 0.5f * x * (1.0f + t); }
__device__ __forceinline__ float logsigf(float x) { return fminf(x, 0.f) - __logf(1.0f + __expf(-fabsf(x))); }
#define LDS_WAIT() asm volatile("s_waitcnt lgkmcnt(0)" ::: "memory")

__device__ __forceinline__ void tr_item(const float* W, int ldw, int nvalid, const float* gain, bf16* WT, int K, int dst_row0, int k0, int n0, LAS float* scr, int lane) {
    const int nq = (lane & 15) * 4, kr = lane >> 4; const bool ok = (n0 + nq) < nvalid;
    f32x4 v[16];
    const float* src = W + (size_t)(k0 + kr) * ldw + n0 + nq;
#pragma unroll
    for (int i = 0; i < 16; ++i) v[i] = ok ? __builtin_nontemporal_load((const f32x4*)(src + (size_t)(4 * i) * ldw)) : (f32x4){0.f, 0.f, 0.f, 0.f};
    if (gain) {
#pragma unroll
        for (int i = 0; i < 16; ++i) v[i] *= gain[k0 + 4 * i + kr]; }
#pragma unroll
    for (int i = 0; i < 16; ++i) { LAS float* d = scr + (4 * i + kr) * 65 + nq; d[0] = v[i][0]; d[1] = v[i][1]; d[2] = v[i][2]; d[3] = v[i][3]; }
    LDS_WAIT(); asm volatile("" ::: "memory");
    const int c = lane >> 3, nn0 = lane & 7;
#pragma unroll
    for (int j = 0; j < 8; ++j) { const int nn = nn0 + 8 * j; const LAS float* s = scr + (8 * c) * 65 + nn;
        u32x4 o; o.x = pk2(s[0 * 65], s[1 * 65]); o.y = pk2(s[2 * 65], s[3 * 65]); o.z = pk2(s[4 * 65], s[5 * 65]); o.w = pk2(s[6 * 65], s[7 * 65]);
        __builtin_nontemporal_store(o, (u32x4*)(WT + (size_t)(dst_row0 + nn) * K + k0 + 8 * c)); }
    LDS_WAIT(); asm volatile("" ::: "memory");
}
__device__ __forceinline__ void p0_prologue(CA a, int l, LAS unsigned char* lds, int gw, int NGW, int wave, int lane) {
    LAS float* scr = (LAS float*)(lds + wave * 16640);
    unsigned char* ws = a->ws;
    constexpr int I_IN = 32 * 84, I_O = 32 * 32, I_G = 32 * 88, I_D = 88 * 32, PER_L = I_IN + I_O + 2 * I_G + I_D;
    unsigned char* wl = ws + WS_W;
    for (int it = gw; it < PER_L; it += NGW) {
        int r = it;
        if (r < I_IN) { const int kb = r / 84, nb = r % 84; tr_item(a->in[I_WIN] + (size_t)l * DM * NIN, NIN, NIN, a->in[I_NMIX] + l * DM, (bf16*)(wl + WL_IN), DM, 64 * nb, 64 * kb, 64 * nb, scr, lane); continue; } r -= I_IN;
        if (r < I_O) { const int kb = r / 32, nb = r % 32; tr_item(a->in[I_WO] + (size_t)l * DM * DM, DM, DM, nullptr, (bf16*)(wl + WL_O), DM, 64 * nb, 64 * kb, 64 * nb, scr, lane); continue; } r -= I_O;
        if (r < I_G) { const int kb = r / 88, nb = r % 88, n0 = 64 * nb; tr_item(a->in[I_WG] + (size_t)l * DM * DFF, DFF, DFF, a->in[I_NFFN] + l * DM, (bf16*)(wl + WL_GU), DM, (n0 >> 7) * 256 + (n0 & 127), 64 * kb, n0, scr, lane); continue; } r -= I_G;
        if (r < I_G) { const int kb = r / 88, nb = r % 88, n0 = 64 * nb; tr_item(a->in[I_WU] + (size_t)l * DM * DFF, DFF, DFF, a->in[I_NFFN] + l * DM, (bf16*)(wl + WL_GU), DM, (n0 >> 7) * 256 + 128 + (n0 & 127), 64 * kb, n0, scr, lane); continue; } r -= I_G;
        { const int kb = r / 32, nb = r % 32; tr_item(a->in[I_WD] + (size_t)l * DFF * DM, DM, DM, nullptr, (bf16*)(wl + (l ? WL_D1 : WL_D)), DFF, 64 * nb, 64 * kb, 64 * nb, scr, lane); }
    }
    if (l != 0) return;
    float* X = a->out + O_Y; bf16* XB = (bf16*)(ws + WS_XB); float* ssq = (float*)(ws + WS_SSQ);
    for (int r0 = gw * 2; r0 < MP; r0 += NGW * 2) {
        f32x4 v[2][8];
#pragma unroll
        for (int q = 0; q < 2; ++q) { const int r = r0 + q; const float* src = r < NPROMPT ? a->in[I_XP] + (size_t)r * DM : a->in[I_XS] + (size_t)(r - NPROMPT) * DM;
#pragma unroll
            for (int j = 0; j < 8; ++j) v[q][j] = r < MR ? *(const f32x4*)(src + 256 * j + 4 * lane) : (f32x4){0.f, 0.f, 0.f, 0.f}; }
#pragma unroll
        for (int q = 0; q < 2; ++q) { const int r = r0 + q; float ss = 0.f;
#pragma unroll
            for (int j = 0; j < 8; ++j) { const f32x4 x = v[q][j]; if (r >= NPROMPT && r < MR) *(f32x4*)(X + (size_t)r * DM + 256 * j + 4 * lane) = x;
                u32x2 w; w.x = pk2(x[0], x[1]); w.y = pk2(x[2], x[3]); *(u32x2*)(XB + (size_t)r * DM + 256 * j + 4 * lane) = w;
                ss += (x[0] * x[0] + x[1] * x[1]) + (x[2] * x[2] + x[3] * x[3]); }
            ss = wave_sum(ss);
            if (lane < 5) ssq[lane * MP + r] = lane == 0 ? ss : 0.f; }
    }
}

constexpr int OFF_B = 0, OFF_QT = 4160, OFF_KT = 8512, OFF_AT = 12864, OFF_V = 17216, OFF_S = 25408;
__device__ __forceinline__ void gla_b(CA a, int l, const bf16* Z, int row0, int h, LAS float* Bm, LAS float* G, int tid) {
    LAS float* glr = G; LAS float* A2h = G + 1024; LAS float* bia = G + 2048; LAS float* seg = G + 2112;
    for (int e = tid; e < 1024; e += 512) { const int i = e >> 4, r = e & 15; glr[e] = bf2f(Z[(size_t)(row0 + i) * NINP + ZLR + r]); }
    for (int e = tid; e < 1024; e += 512) { const int r = e >> 6, d = e & 63; A2h[e] = a->in[I_A2][(l * 16 + r) * 256 + h * 64 + d]; }
    if (tid < 64) bia[tid] = a->in[I_ABIAS][l * 256 + h * 64 + tid];
    __syncthreads();
    { const int i = tid >> 3, d0 = (tid & 7) * 8; float acc[8];
#pragma unroll
        for (int e = 0; e < 8; ++e) acc[e] = bia[d0 + e];
#pragma unroll
        for (int r = 0; r < 16; ++r) { const float g = glr[i * 16 + r];
#pragma unroll
            for (int e = 0; e < 8; ++e) acc[e] += g * A2h[r * 64 + d0 + e]; }
#pragma unroll
        for (int e = 0; e < 8; ++e) Bm[i * 65 + d0 + e] = logsigf(acc[e]) * (1.0f / 16.0f); }
    __syncthreads();
    const int sg = tid >> 6, d = tid & 63;
    { float run = 0.f;
#pragma unroll
        for (int k = 0; k < 8; ++k) { run += Bm[(sg * 8 + k) * 65 + d]; Bm[(sg * 8 + k) * 65 + d] = run; }
        seg[sg * 64 + d] = run; }
    __syncthreads();
    { float pre = 0.f;
#pragma unroll
        for (int s = 0; s < 7; ++s) if (s < sg) pre += seg[s * 64 + d];
#pragma unroll
        for (int k = 0; k < 8; ++k) Bm[(sg * 8 + k) * 65 + d] += pre; }
    __syncthreads();
}

typedef short mf_bf16x8 __attribute__((ext_vector_type(8)));
__device__ __forceinline__ void p2_gla_ds(CA a, int l, int it, LAS unsigned char* lds, int tid) {
    a = fresh_args();
    const int b = it >> 7, c = (it >> 2) & 31, h = it & 3, row0 = b * SEQ + c * 64;
    const bf16* Z = (const bf16*)(a->ws + WS_ZACT);
    LAS float* L = (LAS float*)lds; LAS float* Bm = L; LAS float* G = L + 4160;
    LAS bf16* KPt = (LAS bf16*)(L + 4160 + 4224); LAS bf16* Vt = KPt + 64 * 72;
    __syncthreads();
    gla_b(a, l, Z, row0, h, Bm, G, tid);
    { const int j = tid & 63, dg = tid >> 6; float kv[8]; ld8(Z + (size_t)(row0 + j) * NINP + ZK + h * 64 + dg * 8, kv);
#pragma unroll
        for (int e = 0; e < 8; ++e) { const int d = dg * 8 + e; KPt[d * 72 + j] = (bf16)(pk2(kv[e] * __expf(Bm[63 * 65 + d] - Bm[j * 65 + d]), 0.f) & 0xffffu); } }
#pragma unroll
    for (int q = 0; q < 2; ++q) { const int idx = tid + q * 512, j = idx & 63, dv8 = (idx >> 6) * 8; const u32x4 vr = *(const u32x4*)(Z + (size_t)(row0 + j) * NINP + ZV + h * 128 + dv8);
        const unsigned ww[4] = {vr.x, vr.y, vr.z, vr.w};
#pragma unroll
        for (int e = 0; e < 4; ++e) { Vt[(dv8 + 2 * e) * 72 + j] = (bf16)(ww[e] & 0xffffu); Vt[(dv8 + 2 * e + 1) * 72 + j] = (bf16)(ww[e] >> 16); } }
    __syncthreads();
    { const int wv = tid >> 6, lane = tid & 63, fr = lane & 15, fq = lane >> 4, mi = wv >> 1, nh = wv & 1; f32x4 acc[4];
#pragma unroll
        for (int t = 0; t < 4; ++t) acc[t] = (f32x4){0.f, 0.f, 0.f, 0.f};
#pragma unroll
        for (int ks = 0; ks < 2; ++ks) { const mf_bf16x8 af = *(const LAS mf_bf16x8*)(KPt + (16 * mi + fr) * 72 + 32 * ks + 8 * fq);
#pragma unroll
            for (int t = 0; t < 4; ++t) acc[t] = __builtin_amdgcn_mfma_f32_16x16x32_bf16(*(const LAS mf_bf16x8*)(Vt + (16 * (4 * nh + t) + fr) * 72 + 32 * ks + 8 * fq), af, acc[t], 0, 0, 0); }
        float* DS = (float*)(a->ws + WS_DS) + (size_t)it * 8192 + (16 * mi + fr) * 128;
#pragma unroll
        for (int t = 0; t < 4; ++t) *(f32x4*)(DS + 16 * (4 * nh + t) + 4 * fq) = acc[t]; }
    if (tid < 64) ((float*)(a->ws + WS_DEC))[it * 64 + tid] = __expf(Bm[63 * 65 + tid]);
}

__device__ __forceinline__ void p4_gla_o(CA a, int l, int it, LAS unsigned char* lds, int tid) {
    a = fresh_args();
    const int b = it >> 7, c = (it >> 2) & 31, h = it & 3, row0 = b * SEQ + c * 64;
    const bf16* Z = (const bf16*)(a->ws + WS_ZACT); bf16* MIX = (bf16*)(a->ws + WS_MIX);
    LAS float* L = (LAS float*)lds; LAS float* Bm = L; LAS float* G = L + 4160;
    LAS bf16* Qp = (LAS bf16*)(L + 4160 + 4224); LAS bf16* Kp = Qp + 64 * 72; LAS bf16* Vt = Kp + 64 * 72; LAS bf16* St = Vt + 128 * 72; LAS float* SS = (LAS float*)(St + 128 * 72);
    LAS bf16* ATT = (LAS bf16*)G;
    __syncthreads();
    gla_b(a, l, Z, row0, h, Bm, G, tid);
    { const int i = tid & 63, dg = tid >> 6; float qv[8], kv[8];
        ld8(Z + (size_t)(row0 + i) * NINP + ZQ + h * 64 + dg * 8, qv); ld8(Z + (size_t)(row0 + i) * NINP + ZK + h * 64 + dg * 8, kv);
#pragma unroll
        for (int e = 0; e < 8; ++e) { const float bb = Bm[i * 65 + dg * 8 + e]; qv[e] *= 0.125f * __expf(bb); kv[e] *= __expf(-bb); }
        u32x4 w; w.x = pk2(qv[0], qv[1]); w.y = pk2(qv[2], qv[3]); w.z = pk2(qv[4], qv[5]); w.w = pk2(qv[6], qv[7]); *(LAS u32x4*)(Qp + i * 72 + dg * 8) = w;
        w.x = pk2(kv[0], kv[1]); w.y = pk2(kv[2], kv[3]); w.z = pk2(kv[4], kv[5]); w.w = pk2(kv[6], kv[7]); *(LAS u32x4*)(Kp + i * 72 + dg * 8) = w; }
    { u32x4 vr[2]; f32x4 sr[4]; const float* Sg = (const float*)(a->ws + WS_DS) + (size_t)it * 8192;
#pragma unroll
        for (int q = 0; q < 2; ++q) { const int idx = tid + q * 512, j = idx & 63, dv8 = (idx >> 6) * 8; vr[q] = *(const u32x4*)(Z + (size_t)(row0 + j) * NINP + ZV + h * 128 + dv8); }
#pragma unroll
        for (int q = 0; q < 4; ++q) { const int idx = tid + q * 512, d = idx & 63, dv4 = (idx >> 6) * 4; sr[q] = *(const f32x4*)(Sg + d * 128 + dv4); }
#pragma unroll
        for (int q = 0; q < 2; ++q) { const int idx = tid + q * 512, j = idx & 63, dv8 = (idx >> 6) * 8; const unsigned ww[4] = {vr[q].x, vr[q].y, vr[q].z, vr[q].w};
#pragma unroll
            for (int e = 0; e < 4; ++e) { Vt[(dv8 + 2 * e) * 72 + j] = (bf16)(ww[e] & 0xffffu); Vt[(dv8 + 2 * e + 1) * 72 + j] = (bf16)(ww[e] >> 16); } }
#pragma unroll
        for (int q = 0; q < 4; ++q) { const int idx = tid + q * 512, d = idx & 63, dv4 = (idx >> 6) * 4; const unsigned p0 = pk2(sr[q][0], sr[q][1]), p1 = pk2(sr[q][2], sr[q][3]);
            St[(dv4 + 0) * 72 + d] = (bf16)(p0 & 0xffffu); St[(dv4 + 1) * 72 + d] = (bf16)(p0 >> 16); St[(dv4 + 2) * 72 + d] = (bf16)(p1 & 0xffffu); St[(dv4 + 3) * 72 + d] = (bf16)(p1 >> 16); } }
    __syncthreads();
    const int wv = tid >> 6, lane = tid & 63, fr = lane & 15, fq = lane >> 4, mi = wv >> 1, nh = wv & 1;
    {
        const mf_bf16x8 a0 = *(const LAS mf_bf16x8*)(Qp + (16 * mi + fr) * 72 + 8 * fq), a1 = *(const LAS mf_bf16x8*)(Qp + (16 * mi + fr) * 72 + 32 + 8 * fq);
#pragma unroll
        for (int t = 0; t < 2; ++t) { const int nj = 2 * nh + t; f32x4 at = (f32x4){0.f, 0.f, 0.f, 0.f};
            at = __builtin_amdgcn_mfma_f32_16x16x32_bf16(*(const LAS mf_bf16x8*)(Kp + (16 * nj + fr) * 72 + 8 * fq), a0, at, 0, 0, 0);
            at = __builtin_amdgcn_mfma_f32_16x16x32_bf16(*(const LAS mf_bf16x8*)(Kp + (16 * nj + fr) * 72 + 32 + 8 * fq), a1, at, 0, 0, 0);
            const int i = 16 * mi + fr, j0 = 16 * nj + 4 * fq; u32x2 w;
            w.x = pk2(j0 <= i ? at[0] : 0.f, j0 + 1 <= i ? at[1] : 0.f); w.y = pk2(j0 + 2 <= i ? at[2] : 0.f, j0 + 3 <= i ? at[3] : 0.f);
            *(LAS u32x2*)(ATT + i * 72 + j0) = w; } }
    __syncthreads();
    f32x4 acc[4];
#pragma unroll
    for (int t = 0; t < 4; ++t) acc[t] = (f32x4){0.f, 0.f, 0.f, 0.f};
    const int nks1 = mi < 2 ? 1 : 2;
    for (int ks = 0; ks < nks1; ++ks) { const mf_bf16x8 af = *(const LAS mf_bf16x8*)(ATT + (16 * mi + fr) * 72 + 32 * ks + 8 * fq);
#pragma unroll
        for (int t = 0; t < 4; ++t) acc[t] = __builtin_amdgcn_mfma_f32_16x16x32_bf16(*(const LAS mf_bf16x8*)(Vt + (16 * (4 * nh + t) + fr) * 72 + 32 * ks + 8 * fq), af, acc[t], 0, 0, 0); }
#pragma unroll
    for (int ks = 0; ks < 2; ++ks) { const mf_bf16x8 af = *(const LAS mf_bf16x8*)(Qp + (16 * mi + fr) * 72 + 32 * ks + 8 * fq);
#pragma unroll
        for (int t = 0; t < 4; ++t) acc[t] = __builtin_amdgcn_mfma_f32_16x16x32_bf16(*(const LAS mf_bf16x8*)(St + (16 * (4 * nh + t) + fr) * 72 + 32 * ks + 8 * fq), af, acc[t], 0, 0, 0); }
    { float ss = 0.f;
#pragma unroll
        for (int t = 0; t < 4; ++t) ss += (acc[t][0] * acc[t][0] + acc[t][1] * acc[t][1]) + (acc[t][2] * acc[t][2] + acc[t][3] * acc[t][3]);
        ss += __shfl_xor(ss, 16); ss += __shfl_xor(ss, 32);
        if (fq == 0) SS[(16 * mi + fr) * 2 + nh] = ss; }
    __syncthreads();
    { const int i = 16 * mi + fr; const size_t row = (size_t)(row0 + i); const float rs = rsqrtf((SS[i * 2] + SS[i * 2 + 1]) * (1.0f / 128.0f) + EPS);
#pragma unroll
        for (int t = 0; t < 4; ++t) { const int dv = 16 * (4 * nh + t) + 4 * fq; const f32x4 gn = *(const f32x4*)(a->in[I_GNORM] + l * 512 + h * 128 + dv);
            float gr[4]; ld4(Z + row * NINP + ZR + h * 128 + dv, gr);
            u32x2 w; w.x = pk2(acc[t][0] * rs * gn[0] * siluf(gr[0]), acc[t][1] * rs * gn[1] * siluf(gr[1])); w.y = pk2(acc[t][2] * rs * gn[2] * siluf(gr[2]), acc[t][3] * rs * gn[3] * siluf(gr[3]));
            *(u32x2*)(MIX + row * DM + 512 + h * 128 + dv) = w; } }
}

__device__ __forceinline__ void p4_sgu(CA a, int l, int it, LAS unsigned char* lds, int tid) {
    a = fresh_args();
    const int b = it >> 6, n = (it >> 2) & 15, h = it & 3, row0 = b * SEQ + n * 128;
    const bf16* Z = (const bf16*)(a->ws + WS_ZACT); bf16* MIX = (bf16*)(a->ws + WS_MIX); const bf16* VD = (const bf16*)(a->ws + WS_VD);
    LAS bf16* Wb = (LAS bf16*)lds; LAS bf16* Vt = Wb + 128 * 136;
    __syncthreads();
    const float* sgw = a->in[I_SGW] + (size_t)(l * 4 + h) * 128 * 128;
    { f32x4 w[8]; u32x4 vr[4];
#pragma unroll
        for (int q = 0; q < 8; ++q) { const int ch = tid + q * 512, i = ch >> 5, j4 = (ch & 31) * 4; w[q] = *(const f32x4*)(sgw + i * 128 + j4); }
#pragma unroll
        for (int q = 0; q < 4; ++q) { const int ch = tid + q * 512, j = ch & 127, d8 = (ch >> 7) * 8; vr[q] = *(const u32x4*)(VD + (size_t)(row0 + j) * 512 + h * 128 + d8); }
#pragma unroll
        for (int q = 0; q < 8; ++q) { const int ch = tid + q * 512, i = ch >> 5, j4 = (ch & 31) * 4; f32x4 v = w[q];
#pragma unroll
            for (int e = 0; e < 4; ++e) v[e] = (j4 + e <= i) ? v[e] : 0.f;
            u32x2 o; o.x = pk2(v[0], v[1]); o.y = pk2(v[2], v[3]); *(LAS u32x2*)(Wb + i * 136 + j4) = o; }
#pragma unroll
        for (int q = 0; q < 4; ++q) { const int ch = tid + q * 512, j = ch & 127, d8 = (ch >> 7) * 8; const unsigned ww[4] = {vr[q].x, vr[q].y, vr[q].z, vr[q].w};
#pragma unroll
            for (int e = 0; e < 4; ++e) { Vt[(d8 + 2 * e) * 136 + j] = (bf16)(ww[e] & 0xffffu); Vt[(d8 + 2 * e + 1) * 136 + j] = (bf16)(ww[e] >> 16); } } }
    __syncthreads();
    const int wv = tid >> 6, lane = tid & 63, fr = lane & 15, fq = lane >> 4;
    f32x4 acc[8];
#pragma unroll
    for (int nt = 0; nt < 8; ++nt) acc[nt] = (f32x4){0.f, 0.f, 0.f, 0.f};
    const int nks = (16 * wv + 15) / 32 + 1;
    for (int ks = 0; ks < nks; ++ks) { const mf_bf16x8 af = *(const LAS mf_bf16x8*)(Wb + (16 * wv + fr) * 136 + 32 * ks + 8 * fq);
#pragma unroll
        for (int nt = 0; nt < 8; ++nt) { const mf_bf16x8 bfr = *(const LAS mf_bf16x8*)(Vt + (16 * nt + fr) * 136 + 32 * ks + 8 * fq);
            acc[nt] = __builtin_amdgcn_mfma_f32_16x16x32_bf16(bfr, af, acc[nt], 0, 0, 0); } }
    { const int i = 16 * wv + fr; const size_t row = (size_t)(row0 + i); const float bs = a->in[I_SGB][(l * 4 + h) * 128 + i];
#pragma unroll
        for (int nt = 0; nt < 8; ++nt) { const int d = 16 * nt + 4 * fq; float up[4]; ld4(Z + row * NINP + ZD + h * 128 + d, up);
            u32x2 o; o.x = pk2(geluf(up[0]) * (acc[nt][0] + bs), geluf(up[1]) * (acc[nt][1] + bs)); o.y = pk2(geluf(up[2]) * (acc[nt][2] + bs), geluf(up[3]) * (acc[nt][3] + bs));
            *(u32x2*)(MIX + row * DM + 1536 + h * 128 + d) = o; } }
}

__device__ __forceinline__ void p2_conf(CA a, int l, int it, LAS unsigned char* lds, int tid, int wave, int lane) {
    a = fresh_args();
    const int b = it >> 6, tile = it & 63, t0 = tile * 32;
    const bf16* Z = (const bf16*)(a->ws + WS_ZACT); bf16* MIX = (bf16*)(a->ws + WS_MIX);
    LAS float* CIN = (LAS float*)lds;
    float w[31]; const float* cw = a->in[I_CCW] + (size_t)l * 31 * 512 + tid;
#pragma unroll
    for (int j = 0; j < 31; ++j) w[j] = cw[j * 512];
    const float bsv = a->in[I_CCB][l * 512 + tid];
    __syncthreads();
    { const int rr = tid >> 6, c8 = (tid & 63) * 8; u32x4 ga[8], gb[8];
#pragma unroll
        for (int p = 0; p < 8; ++p) { const int i = p * 8 + rr, t = t0 - 30 + i; ga[p] = (u32x4){0u, 0u, 0u, 0u}; gb[p] = ga[p];
            if (i < 62 && t >= 0) { const bf16* zr = Z + (size_t)(b * SEQ + t) * NINP + ZC + c8; ga[p] = *(const u32x4*)zr; gb[p] = *(const u32x4*)(zr + 512); } }
#pragma unroll
        for (int p = 0; p < 8; ++p) { const int i = p * 8 + rr; if (i < 62) { float fa[8], fb[8], cv[8]; up8(ga[p], fa); up8(gb[p], fb);
#pragma unroll
                for (int e = 0; e < 8; ++e) cv[e] = fa[e] * sigmf(fb[e]);
                *(LAS f32x4*)(CIN + i * 512 + c8) = (f32x4){cv[0], cv[1], cv[2], cv[3]}; *(LAS f32x4*)(CIN + i * 512 + c8 + 4) = (f32x4){cv[4], cv[5], cv[6], cv[7]};
                if (tile == 63 && i >= 32) stf8(a->out + O_CCP + ((size_t)(l * 4 + b) * 30 + (i - 32)) * 512 + c8, cv); } } }
    __syncthreads();
    { const int c = tid; float acc[32];
#pragma unroll
        for (int t = 0; t < 32; ++t) acc[t] = bsv;
#pragma unroll
        for (int i = 0; i < 62; ++i) { const float v = CIN[i * 512 + c];
#pragma unroll
            for (int t = 0; t < 32; ++t) { if (i - t >= 0 && i - t <= 30) acc[t] += w[i - t] * v; } }
        __syncthreads();
#pragma unroll
        for (int t = 0; t < 32; ++t) CIN[t * 512 + c] = acc[t]; }
    __syncthreads();
    { float g[8], bt[8]; ldf8(a->in[I_LNCG] + l * 512 + lane * 8, g); ldf8(a->in[I_LNCB] + l * 512 + lane * 8, bt);
#pragma unroll
        for (int rr = 0; rr < 4; ++rr) { const int t = wave * 4 + rr; float v[8];
            { const f32x4 x0 = *(const LAS f32x4*)(CIN + t * 512 + lane * 8), x1 = *(const LAS f32x4*)(CIN + t * 512 + lane * 8 + 4); v[0] = x0[0]; v[1] = x0[1]; v[2] = x0[2]; v[3] = x0[3]; v[4] = x1[0]; v[5] = x1[1]; v[6] = x1[2]; v[7] = x1[3]; }
            float s = 0.f;
#pragma unroll
            for (int e = 0; e < 8; ++e) s += v[e];
            const float mu = wave_sum(s) * (1.0f / 512.0f); float q = 0.f;
#pragma unroll
            for (int e = 0; e < 8; ++e) { v[e] -= mu; q += v[e] * v[e]; }
            const float rstd = rsqrtf(wave_sum(q) * (1.0f / 512.0f) + EPS); float y[8];
#pragma unroll
            for (int e = 0; e < 8; ++e) y[e] = siluf(v[e] * rstd * g[e] + bt[e]);
            st8(MIX + (size_t)(b * SEQ + t0 + t) * DM + 1024 + lane * 8, y); } }
}
__device__ __forceinline__ void p2_conf_sample_w(CA a, int l, int s, int lane) {
    a = fresh_args();
    const bf16* Z = (const bf16*)(a->ws + WS_ZACT); bf16* MIX = (bf16*)(a->ws + WS_MIX);
    const int c8 = lane * 8; const size_t row = (size_t)(NPROMPT + s);
    float ga[8], gb[8], cin[8], acc[8], w[8];
    ld8(Z + row * NINP + ZC + c8, ga); ld8(Z + row * NINP + ZC + 512 + c8, gb);
    const float* cw = a->in[I_CCW] + (size_t)l * 31 * 512 + c8; ldf8(a->in[I_CCB] + l * 512 + c8, acc); ldf8(cw + 30 * 512, w);
#pragma unroll
    for (int e = 0; e < 8; ++e) { cin[e] = ga[e] * sigmf(gb[e]); acc[e] += w[e] * cin[e]; }
    const float* past = a->in[I_SCC] + ((size_t)(l * 128 + s) * 30) * 512 + c8; float* nc = a->out + O_CCS + ((size_t)(l * 128 + s) * 30) * 512 + c8;
#pragma unroll 1
    for (int jb = 0; jb < 30; jb += 6) { float pv[6][8], wv[6][8];
#pragma unroll
        for (int j = 0; j < 6; ++j) { ldf8(past + (jb + j) * 512, pv[j]); ldf8(cw + (jb + j) * 512, wv[j]); }
#pragma unroll
        for (int j = 0; j < 6; ++j) {
#pragma unroll
            for (int e = 0; e < 8; ++e) acc[e] += wv[j][e] * pv[j][e];
            if (jb + j >= 1) stf8(nc + (jb + j - 1) * 512, pv[j]); } }
    stf8(nc + 29 * 512, cin);
    float sm = 0.f;
#pragma unroll
    for (int e = 0; e < 8; ++e) sm += acc[e];
    const float mu = wave_sum(sm) * (1.0f / 512.0f); float q = 0.f;
#pragma unroll
    for (int e = 0; e < 8; ++e) { acc[e] -= mu; q += acc[e] * acc[e]; }
    const float rstd = rsqrtf(wave_sum(q) * (1.0f / 512.0f) + EPS); float g[8], bt[8], y[8];
    ldf8(a->in[I_LNCG] + l * 512 + c8, g); ldf8(a->in[I_LNCB] + l * 512 + c8, bt);
#pragma unroll
    for (int e = 0; e < 8; ++e) y[e] = siluf(acc[e] * rstd * g[e] + bt[e]);
    st8(MIX + row * DM + 1024 + c8, y);
}
__device__ __forceinline__ void p2_gla_sample_w(CA a, int l, int it, int lane) {
    a = fresh_args();
    const int s = it >> 2, h = it & 3; const size_t row = (size_t)(NPROMPT + s);
    const bf16* Z = (const bf16*)(a->ws + WS_ZACT); bf16* MIX = (bf16*)(a->ws + WS_MIX);
    float acc = a->in[I_ABIAS][l * 256 + h * 64 + lane];
    { float g[8], g2[8]; ld8(Z + row * NINP + ZLR, g); ld8(Z + row * NINP + ZLR + 8, g2);
#pragma unroll
        for (int r = 0; r < 8; ++r) acc += g[r] * a->in[I_A2][(l * 16 + r) * 256 + h * 64 + lane];
#pragma unroll
        for (int r = 0; r < 8; ++r) acc += g2[r] * a->in[I_A2][(l * 16 + 8 + r) * 256 + h * 64 + lane]; }
    const float av = __expf(logsigf(acc) * (1.0f / 16.0f)), qv = bf2f(Z[row * NINP + ZQ + h * 64 + lane]) * 0.125f, kv = bf2f(Z[row * NINP + ZK + h * 64 + lane]);
    const unsigned vw = *(const unsigned*)(Z + row * NINP + ZV + h * 128 + lane * 2); const float v0 = bflo(vw), v1 = bfhi(vw);
    const size_t so = ((size_t)((l * 128 + s) * 4 + h) * 64) * 128;
    const float* S0 = a->in[I_SGLA] + so + lane * 2; float* Sn = a->out + O_GS + so + lane * 2; float o0 = 0.f, o1 = 0.f;
#pragma unroll 1
    for (int db = 0; db < 64; db += 32) { f32x2 sv[32];
#pragma unroll
        for (int j = 0; j < 32; ++j) sv[j] = *(const f32x2*)(S0 + (db + j) * 128);
#pragma unroll
        for (int j = 0; j < 32; ++j) { const int d = db + j;
            const float ad = __int_as_float(__builtin_amdgcn_readlane(__float_as_int(av), d)), kd = __int_as_float(__builtin_amdgcn_readlane(__float_as_int(kv), d)), qd = __int_as_float(__builtin_amdgcn_readlane(__float_as_int(qv), d));
            f32x2 t; t.x = ad * sv[j].x + kd * v0; t.y = ad * sv[j].y + kd * v1; *(f32x2*)(Sn + d * 128) = t; o0 += qd * t.x; o1 += qd * t.y; } }
    const float rs = rsqrtf(wave_sum(o0 * o0 + o1 * o1) * (1.0f / 128.0f) + EPS);
    const float g0 = a->in[I_GNORM][l * 512 + h * 128 + lane * 2], g1 = a->in[I_GNORM][l * 512 + h * 128 + lane * 2 + 1];
    const unsigned grw = *(const unsigned*)(Z + row * NINP + ZR + h * 128 + lane * 2);
    *(unsigned*)(MIX + row * DM + 512 + h * 128 + lane * 2) = pk2(o0 * rs * g0 * siluf(bflo(grw)), o1 * rs * g1 * siluf(bfhi(grw)));
}
struct RowIn { u32x4 ax, ac, ab, ax1, ac1, ax2, ac2, vv, uu; };
__device__ __forceinline__ void p2_row_load(CA a, int l, int r, int lane, RowIn& R) {
    a = fresh_args();
    const bf16* zr = (const bf16*)(a->ws + WS_ZACT) + (size_t)r * NINP; const int c0 = lane * 8; const bool smp = r >= NPROMPT; const int t = r & 2047, s = r - NPROMPT;
    const u32x4 z4 = (u32x4){0u, 0u, 0u, 0u};
    R.ax = *(const u32x4*)(zr + ZAX + c0); R.ac = *(const u32x4*)(zr + ZAC + c0); R.ab = *(const u32x4*)(zr + ZAB + c0); R.vv = *(const u32x4*)(zr + ZD + 512 + c0);
    R.ax1 = z4; R.ac1 = z4; R.ax2 = z4; R.ac2 = z4; R.uu = z4;
    if (smp) { const float* st = a->in[I_SCA] + ((size_t)(l * 128 + s) * 2) * 512 + c0; R.ax2 = *(const u32x4*)st; R.ac2 = *(const u32x4*)(st + 4); R.ax1 = *(const u32x4*)(st + 512); R.ac1 = *(const u32x4*)(st + 516); R.uu = *(const u32x4*)(zr + ZD + c0); }
    else { if (t >= 1) { R.ax1 = *(const u32x4*)(zr - NINP + ZAX + c0); R.ac1 = *(const u32x4*)(zr - NINP + ZAC + c0); }
           if (t >= 2) { R.ax2 = *(const u32x4*)(zr - 2 * NINP + ZAX + c0); R.ac2 = *(const u32x4*)(zr - 2 * NINP + ZAC + c0); } }
}
__device__ __forceinline__ void p2_row_compute(CA a, int l, int r, int lane, const RowIn& R) {
    a = fresh_args();
    bf16* MIX = (bf16*)(a->ws + WS_MIX); bf16* VD = (bf16*)(a->ws + WS_VD);
    const int c0 = lane * 8; const bool smp = r >= NPROMPT; const int b = r >> 11, t = r & 2047, s = r - NPROMPT;
    float ax[8], ac[8], ab[8], p0[8], p1[8], p2[8], w0[8], w1[8], w2[8], y[8];
    up8(R.ax, ax); up8(R.ac, ac); up8(R.ab, ab);
#pragma unroll
    for (int e = 0; e < 8; ++e) p0[e] = ac[e] * ax[e];
    if (smp) { p1[0] = __uint_as_float(R.ax1.x); p1[1] = __uint_as_float(R.ax1.y); p1[2] = __uint_as_float(R.ax1.z); p1[3] = __uint_as_float(R.ax1.w); p1[4] = __uint_as_float(R.ac1.x); p1[5] = __uint_as_float(R.ac1.y); p1[6] = __uint_as_float(R.ac1.z); p1[7] = __uint_as_float(R.ac1.w);
               p2[0] = __uint_as_float(R.ax2.x); p2[1] = __uint_as_float(R.ax2.y); p2[2] = __uint_as_float(R.ax2.z); p2[3] = __uint_as_float(R.ax2.w); p2[4] = __uint_as_float(R.ac2.x); p2[5] = __uint_as_float(R.ac2.y); p2[6] = __uint_as_float(R.ac2.z); p2[7] = __uint_as_float(R.ac2.w); }
    else { up8(R.ax1, ax); up8(R.ac1, ac);
#pragma unroll
        for (int e = 0; e < 8; ++e) p1[e] = ac[e] * ax[e];
        up8(R.ax2, ax); up8(R.ac2, ac);
#pragma unroll
        for (int e = 0; e < 8; ++e) p2[e] = ac[e] * ax[e]; }
    ldf8(a->in[I_CAW] + (l * 3 + 0) * 512 + c0, w0); ldf8(a->in[I_CAW] + (l * 3 + 1) * 512 + c0, w1); ldf8(a->in[I_CAW] + (l * 3 + 2) * 512 + c0, w2);
#pragma unroll
    for (int e = 0; e < 8; ++e) y[e] = ab[e] * (w0[e] * p2[e] + w1[e] * p1[e] + w2[e] * p0[e]);
    st8(MIX + (size_t)r * DM + c0, y);
    if (smp) { stf8(a->out + O_CAS + ((size_t)(l * 128 + s) * 2 + 0) * 512 + c0, p1); stf8(a->out + O_CAS + ((size_t)(l * 128 + s) * 2 + 1) * 512 + c0, p0); }
    else if (t >= SEQ - 2) stf8(a->out + O_CAP + ((size_t)(l * 4 + b) * 2 + (t - (SEQ - 2))) * 512 + c0, p0);
    float v[8], g[8], bt[8]; up8(R.vv, v); float sm = 0.f;
#pragma unroll
    for (int e = 0; e < 8; ++e) { v[e] = geluf(v[e]); sm += v[e]; }
    const float mu = wave_sum(sm) * (1.0f / 512.0f); float q = 0.f;
#pragma unroll
    for (int e = 0; e < 8; ++e) { v[e] -= mu; q += v[e] * v[e]; }
    const float rstd = rsqrtf(wave_sum(q) * (1.0f / 512.0f) + EPS);
    ldf8(a->in[I_LNDG] + l * 512 + c0, g); ldf8(a->in[I_LNDB] + l * 512 + c0, bt);
#pragma unroll
    for (int e = 0; e < 8; ++e) v[e] = v[e] * rstd * g[e] + bt[e];
    if (smp) { stf8(a->out + O_SVS + (size_t)(l * 128 + s) * 512 + c0, v);
        const int h = c0 >> 7; const float w00 = a->in[I_SGW][(size_t)(l * 4 + h) * 128 * 128], b00 = a->in[I_SGB][(l * 4 + h) * 128]; float up[8];
        up8(R.uu, up);
#pragma unroll
        for (int e = 0; e < 8; ++e) y[e] = geluf(up[e]) * (w00 * v[e] + b00);
        st8(MIX + (size_t)r * DM + 1536 + c0, y); }
    else { st8(VD + (size_t)r * 512 + c0, v); if (t >= SEQ - 128) stf8(a->out + O_SVP + ((size_t)(l * 4 + b) * 128 + (t - (SEQ - 128))) * 512 + c0, v); }
}

#define XB_TMO      128
#define XB_XCNT(j)  (256  + 64 * (j))
#define XB_XSUB(j)  (1280 + 64 * (j))
#define XB_XGEN(j)  (2304 + 64 * (j))
#define XB_TOP      3328
#define XB_TOPGEN   3392
#define XCD_BAR_WORDS 3456
#define XB_SPIN_CAP (1u << 18)

__device__ __forceinline__ unsigned xb_ld(unsigned* p)              { return __hip_atomic_load(p, __ATOMIC_RELAXED, __HIP_MEMORY_SCOPE_AGENT); }
__device__ __forceinline__ unsigned xb_add(unsigned* p, unsigned v) { return __hip_atomic_fetch_add(p, v, __ATOMIC_RELAXED, __HIP_MEMORY_SCOPE_AGENT); }
__device__ __forceinline__ unsigned xb_xcc_id() { return (unsigned)__builtin_amdgcn_s_getreg((3 << 11) | 20) & 0xFu; }
#define XB_SPIN(cond, bar) do { unsigned _sp = 0; while (cond) { __builtin_amdgcn_s_sleep(1); \
    if ((++_sp & 255u) == 0u) { if (xb_ld(&(bar)[XB_TMO])) break; if (_sp > XB_SPIN_CAP) { atomicAdd(&(bar)[XB_TMO], 1u); break; } } } } while (0)

struct XcdBarrier {
    unsigned* bar; unsigned x;
    volatile LAS unsigned* st;
};

__device__ __forceinline__ XcdBarrier xcd_barrier_post(unsigned* bar, volatile LAS unsigned* st) {
    XcdBarrier b; b.bar = bar; b.x = xb_xcc_id(); b.st = st;
    if (threadIdx.x == 0) (void)xb_add(&bar[XB_XCNT(b.x)], 1u);
    return b;
}
__device__ __forceinline__ void xcd_barrier_complete(unsigned* bar, unsigned x, unsigned& nloc, unsigned& nx) {
    const unsigned G = gridDim.x * gridDim.y * gridDim.z;
    unsigned sum, cnt, mine, sp = 0u;
    for (;;) {
        sum = 0u; cnt = 0u; mine = 0u;
#pragma unroll
        for (unsigned j = 0; j < 16; ++j) { const unsigned c = xb_ld(&bar[XB_XCNT(j)]); sum += c; cnt += (c > 0u) ? 1u : 0u; mine = (j == x) ? c : mine; }
        if (sum == G) break;
        __builtin_amdgcn_s_sleep(1);
        if ((++sp & 255u) == 0u) { if (xb_ld(&bar[XB_TMO])) break; if (sp > XB_SPIN_CAP) { atomicAdd(&bar[XB_TMO], 1u); break; } }
    }
    nloc = mine > 0u ? mine : 1u; nx = cnt > 0u ? cnt : 1u;
}

__device__ __forceinline__ void xcd_barrier(const XcdBarrier& b) {
    asm volatile("s_waitcnt vmcnt(0)" ::: "memory");
    __syncthreads();
    if (threadIdx.x == 0) {
        unsigned* bar = b.bar;
        __builtin_amdgcn_s_waitcnt(0);
        unsigned nloc = b.st[0], nx = b.st[1];
        if (nloc == 0u) { xcd_barrier_complete(bar, b.x, nloc, nx); b.st[0] = nloc; b.st[1] = nx; }
        const unsigned old = xb_add(&bar[XB_XSUB(b.x)], 1u);
        const unsigned gen = old / nloc;
        if (old + 1u == (gen + 1u) * nloc) {
            __builtin_amdgcn_fence(__ATOMIC_RELEASE, "agent");
            asm volatile("s_waitcnt vmcnt(0)" ::: "memory");
            const unsigned og = xb_add(&bar[XB_TOP], 1u);
            const unsigned tg = og / nx;
            if (og + 1u == (tg + 1u) * nx) xb_add(&bar[XB_TOPGEN], 1u);
            else XB_SPIN(xb_ld(&bar[XB_TOPGEN]) == tg, bar);
            __builtin_amdgcn_fence(__ATOMIC_ACQUIRE, "agent");
            xb_add(&bar[XB_XGEN(b.x)], 1u);
            asm volatile("s_waitcnt vmcnt(0)" ::: "memory");
        } else {
            XB_SPIN(xb_ld(&bar[XB_XGEN(b.x)]) == gen, bar);
            __builtin_amdgcn_fence(__ATOMIC_ACQUIRE, "agent");
            asm volatile("s_waitcnt vmcnt(0)" ::: "memory");
        }
    }
    __syncthreads();
}

#ifndef REP_P1
#define REP_P1 1
#endif
#ifndef REP_P6
#define REP_P6 1
#endif
#ifndef REP_GDS
#define REP_GDS 1
#endif
#ifndef REP_CONF
#define REP_CONF 1
#endif
#ifndef REP_WI
#define REP_WI 1
#endif
#ifndef REP_P0
#define REP_P0 1
#endif
#ifndef REP_P2
#define REP_P2 1
#endif
#ifndef REP_P4
#define REP_P4 1
#endif
#define FRESH() int tid = threadIdx.x; asm volatile("" : "+v"(tid)); const int lane = tid & 63, wave = __builtin_amdgcn_readfirstlane(tid >> 6), blk = blockIdx.x, nblk = gridDim.x; CA a = fresh_args(); unsigned char* ws = a->ws; (void)lane; (void)wave; (void)blk; (void)nblk; (void)ws
__global__ void __launch_bounds__(512, 2) mk_fwd(Args kargs) {
    extern __shared__ __attribute__((aligned(16))) unsigned char lds_raw[];
    LAS unsigned char* lds = (LAS unsigned char*)lds_raw;
    cg::grid_group grid = cg::this_grid();
    volatile LAS unsigned* bst = (volatile LAS unsigned*)(lds + LDS_BYTES - 64);
    { FRESH(); if (tid < 16) bst[tid] = 0u; __syncthreads();
      if (a->pad0 == 0x5eed5eed) grid.sync();
      (void)xcd_barrier_post((unsigned*)(ws + WS_BAR), bst); }
#define SEAM() do { CA a_ = fresh_args(); XcdBarrier xb_; xb_.bar = (unsigned*)(a_->ws + WS_BAR); xb_.x = xb_xcc_id(); xb_.st = bst; xcd_barrier(xb_); } while (0)
#pragma unroll 1
    for (int l = 0; l < 2; ++l) {
#ifndef NO_P0
        for (int rep = 0; rep < REP_P0; ++rep) { FRESH(); p0_prologue(a, l, lds, blk * 8 + wave, nblk * 8, wave, lane); }
#endif
        SEAM();
#ifndef NO_P1
        {
            FRESH(); unsigned char* wl = ws + WS_W;
            pg8::Gemm g{(const bf16*)(ws + WS_XB), (const bf16*)(wl + WL_IN), MP, NINP, DM}; pg8::StaticOrder S; S.init(MP, NINP, nblk, blk, DM);
            pg8::EpiZ E{(bf16*)(ws + WS_ZACT), NINP, (const float*)(ws + WS_SSQ) + (2 * l) * MP};
            for (int rep = 0; rep < REP_P1; ++rep) pg8::gemm_phase<pg8::EpiZ, pg8::StaticOrder, true, true>(lds, g, S, E);
        }
#endif
        SEAM();
#ifndef NO_P2
        {
            FRESH();
            for (int it = blk; it < 768; it += nblk) {
                if (it < 512) { for (int rep = 0; rep < REP_GDS; ++rep) p2_gla_ds(a, l, it, lds, tid); }
                else { for (int rep = 0; rep < REP_CONF; ++rep) p2_conf(a, l, it - 512, lds, tid, wave, lane); }
            }
            if (nblk == 256) {
                const int gwv = blk * 8 + wave, g16 = gwv >> 4, w16 = gwv & 15;
                if (w16 < 5) { const int si = g16 * 5 + w16; if (si < 512) p2_gla_sample_w(a, l, si, lane); else p2_conf_sample_w(a, l, si - 512, lane);
                    const int r0 = 7040 + si * 2; RowIn R0, R1; p2_row_load(a, l, r0, lane, R0); p2_row_load(a, l, r0 + 1, lane, R1); p2_row_compute(a, l, r0, lane, R0); p2_row_compute(a, l, r0 + 1, lane, R1); }
                else { const int r0 = (g16 * 11 + (w16 - 5)) * 5;
#pragma unroll 1
                    for (int q = 0; q < 2; ++q) { RowIn R0, R1; p2_row_load(a, l, r0 + 2 * q, lane, R0); p2_row_load(a, l, r0 + 2 * q + 1, lane, R1); p2_row_compute(a, l, r0 + 2 * q, lane, R0); p2_row_compute(a, l, r0 + 2 * q + 1, lane, R1); }
                    { RowIn R0; p2_row_load(a, l, r0 + 4, lane, R0); p2_row_compute(a, l, r0 + 4, lane, R0); } }
            } else {
                for (int wi = blk * 8 + wave; wi < 4160 + 512 + 128; wi += nblk * 8) {
                    if (wi < 4160) { const int r0 = wi * 2; RowIn R0, R1; p2_row_load(a, l, r0, lane, R0); p2_row_load(a, l, r0 + 1, lane, R1); p2_row_compute(a, l, r0, lane, R0); p2_row_compute(a, l, r0 + 1, lane, R1); }
                    else if (wi < 4672) p2_gla_sample_w(a, l, wi - 4160, lane);
                    else p2_conf_sample_w(a, l, wi - 4672, lane);
                }
            }
        }
#endif
        SEAM();
        {
            FRESH();
            for (int gidx = blk * 512 + tid; gidx < 131072; gidx += nblk * 512) {
                const int bh = gidx >> 13, b = bh >> 2, h = bh & 3, e = gidx & 8191, d = e >> 7;
                float* DS = (float*)(ws + WS_DS); const float* dec = (const float*)(ws + WS_DEC); float Sv = 0.f;
                { float dsv[32], dcv[32];
#pragma unroll
                    for (int c = 0; c < 32; ++c) { const int itc = (b * 32 + c) * 4 + h; dsv[c] = DS[(size_t)itc * 8192 + e]; dcv[c] = dec[itc * 64 + d]; }
#pragma unroll
                    for (int c = 0; c < 32; ++c) { const int itc = (b * 32 + c) * 4 + h; DS[(size_t)itc * 8192 + e] = Sv; Sv = dcv[c] * Sv + dsv[c]; } }
                a->out[O_GP + (size_t)((l * 4 + b) * 4 + h) * 8192 + e] = Sv;
            }
        }
        SEAM();
#ifndef NO_P4
        {
            FRESH();
            for (int rep = 0; rep < REP_P4; ++rep)
            for (int it = blk; it < 768; it += nblk) { if (it < 512) p4_gla_o(a, l, it, lds, tid); else p4_sgu(a, l, it - 512, lds, tid); }
        }
#endif
        SEAM();
#ifndef NO_P5
        {
            FRESH(); unsigned char* wl = ws + WS_W;
            pg8::Gemm g{(const bf16*)(ws + WS_MIX), (const bf16*)(wl + WL_O), MP, DM, DM}; pg8::SplitOrder S; S.init(DM, nblk, blk, DM, 8);
            pg8::EpiRes<8> E{a->out + O_Y, (bf16*)(ws + WS_XB), (float*)(ws + WS_SSQ) + (2 * l + 1) * MP, (unsigned*)(ws + WS_CNT) + (2 * l) * 64, 8, (float*)(ws + WS_PART)};
            pg8::gemm_phase<pg8::EpiRes<8>, pg8::SplitOrder, true, true>(lds, g, S, E);
        }
#endif
        SEAM();
#ifndef NO_P6
        {
            FRESH(); unsigned char* wl = ws + WS_W;
            pg8::Gemm g{(const bf16*)(ws + WS_XB), (const bf16*)(wl + WL_GU), MP, 2 * DFF, DM}; pg8::StaticOrder S; S.init(MP, 2 * DFF, nblk, blk, DM);
            pg8::EpiGU E{(bf16*)(ws + WS_ZACT), DFF, (const float*)(ws + WS_SSQ) + (2 * l + 1) * MP};
            for (int rep = 0; rep < REP_P6; ++rep) pg8::gemm_phase<pg8::EpiGU, pg8::StaticOrder, true, true>(lds, g, S, E);
        }
#endif
        SEAM();
#ifndef NO_P7
        {
            FRESH(); unsigned char* wl = ws + WS_W;
            pg8::Gemm g{(const bf16*)(ws + WS_ZACT), (const bf16*)(wl + (l ? WL_D1 : WL_D)), MP, DM, DFF}; pg8::SplitOrder S; S.init(DM, nblk, blk, DFF, 11);
            pg8::EpiRes<11> E{a->out + O_Y, (bf16*)(ws + WS_XB), (float*)(ws + WS_SSQ) + (2 * l + 2) * MP, (unsigned*)(ws + WS_CNT) + (2 * l + 1) * 64, 11, (float*)(ws + WS_PART)};
            pg8::gemm_phase<pg8::EpiRes<11>, pg8::SplitOrder, true, true>(lds, g, S, E);
        }
#endif
        if (l == 1) SEAM();
    }
#ifdef EXTRA_SYNCS
    for (int q = 0; q < EXTRA_SYNCS; ++q) SEAM();
#endif
    {
        FRESH(); float* Y = a->out + O_Y; const bf16* XB = (const bf16*)(ws + WS_XB);
        for (int r0 = (blk * 8 + wave) * 2; r0 < MR; r0 += nblk * 16) {
            f32x4 v[2][8];
#pragma unroll
            for (int q = 0; q < 2; ++q) { const int r = r0 + q;
                if (r < NPROMPT) {
#pragma unroll
                    for (int j = 0; j < 8; ++j) { float t[4]; ld4(XB + (size_t)r * DM + 256 * j + 4 * lane, t); v[q][j] = (f32x4){t[0], t[1], t[2], t[3]}; }
                } else {
#pragma unroll
                    for (int j = 0; j < 8; ++j) v[q][j] = *(const f32x4*)(Y + (size_t)r * DM + 256 * j + 4 * lane);
                } }
            f32x4 gn[8];
#pragma unroll
            for (int j = 0; j < 8; ++j) gn[j] = *(const f32x4*)(a->in[I_NFIN] + 256 * j + 4 * lane);
#pragma unroll
            for (int q = 0; q < 2; ++q) { const int r = r0 + q; float ss = 0.f;
#pragma unroll
                for (int j = 0; j < 8; ++j) ss += (v[q][j][0] * v[q][j][0] + v[q][j][1] * v[q][j][1]) + (v[q][j][2] * v[q][j][2] + v[q][j][3] * v[q][j][3]);
                const float rs = rsqrtf(wave_sum(ss) * (1.0f / 2048.0f) + EPS);
#pragma unroll
                for (int j = 0; j < 8; ++j) *(f32x4*)(Y + (size_t)r * DM + 256 * j + 4 * lane) = v[q][j] * rs * gn[j]; }
        }
    }
}

extern "C" void kernel_launch(void* const* d_in, const int* in_sizes, int n_in, void* d_out, int out_size, void* d_ws, size_t ws_size, hipStream_t stream) {
    static int grid = 0;
    if (grid == 0) {
        int dev = 0, cus = 0, per_cu = 0;
        if (n_in != 25 || out_size != 30670848 || ws_size < WS_END) { fprintf(stderr, "kernel_launch: unexpected shapes (n_in %d out %d ws %zu, need %zu)\n", n_in, out_size, ws_size, (size_t)WS_END); grid = -1; return; }
        (void)hipGetDevice(&dev);
        (void)hipDeviceGetAttribute(&cus, hipDeviceAttributeMultiprocessorCount, dev);
        (void)hipFuncSetAttribute((const void*)mk_fwd, hipFuncAttributeMaxDynamicSharedMemorySize, LDS_BYTES);
        (void)hipOccupancyMaxActiveBlocksPerMultiprocessor(&per_cu, (const void*)mk_fwd, 512, LDS_BYTES);
        if (per_cu < 1) { fprintf(stderr, "kernel_launch: occupancy query reports %d blocks per CU\n", per_cu); grid = -1; return; }
        grid = cus;
    }
    if (grid < 0) return;
    (void)hipMemsetAsync((unsigned char*)d_ws + WS_BAR, 0, 256 * 1024, stream);
    Args ha{};
    for (int i = 0; i < 25; ++i) ha.in[i] = (const float*)d_in[i];
    ha.out = (float*)d_out; ha.ws = (unsigned char*)d_ws; ha.pad0 = 0; ha.pad1 = 0;
    void* args[] = {&ha};
    hipError_t e = hipLaunchCooperativeKernel((void*)mk_fwd, dim3(grid), dim3(512), args, LDS_BYTES, stream);
    if (e != hipSuccess) fprintf(stderr, "cooperative launch failed: %s (grid %d)\n", hipGetErrorString(e), grid);
}
```

```cpp
#include <hip/hip_runtime.h>
#include <hip/hip_cooperative_groups.h>
#include <cstdio>
#include <cstdint>
namespace cg = cooperative_groups;

constexpr int DM = 2048, NPROMPT = 8192, MR = 8320, MP = 8448, NIN = 5136, NINP = 5376, DFF = 5632, SEQ = 2048;
constexpr int ZAX = 0, ZAB = 512, ZAC = 1024, ZQ = 1536, ZK = 1792, ZV = 2048, ZR = 2560, ZLR = 3072, ZC = 3088, ZD = 4112;
constexpr float EPS = 1e-6f;

namespace pg8 {
#define PG8_LAS __attribute__((address_space(3)))
typedef unsigned short bf16_t;
typedef short bf16x8 __attribute__((ext_vector_type(8)));
typedef float f32x4 __attribute__((ext_vector_type(4)));
typedef unsigned u32x4 __attribute__((ext_vector_type(4)));
constexpr int BM = 256, BK = 64, HALF = 128, HTB = HALF * BK * 2  , STAGE_BYTES = 8 * HTB, NXCD = 8, WGM = 4;

__host__ __device__ __forceinline__ int lds_byte(int r, int c) { const int st = (r >> 4) * 2 + (c >> 5), rr = r & 15, cc = c & 31, ob = rr * 64 + cc * 2; return st * 1024 + (ob ^ (((ob >> 9) & 1) << 5)); }
__host__ __device__ __forceinline__ void stage_rc(int b, int& R, int& C) { const int st = b / 1024, sb = b % 1024, swz = sb ^ (((sb >> 9) & 1) << 5); R = (st >> 1) * 16 + swz / 64; C = (st & 1) * 32 + (swz % 64) / 2; }
__host__ __device__ __forceinline__ int perm32(int rho) { const int n = rho >> 4, i = rho & 15; return 8 * (i >> 2) + 4 * n + (i & 3); }

struct Unit { int pm, pn, k0, nt, kind; };
struct Gemm { const bf16_t* A; const bf16_t* Bt; int M, N, K; };

struct StaticOrder {
    int nM, nN, nwg, G, c, ntk;
    __host__ __device__ void init(int M, int N, int G_, int c_, int K) { nM = M / BM; nN = N / BM; nwg = nM * nN; G = G_; c = c_; ntk = K / BK; }
    __host__ __device__ bool next(int i, Unit& u) const {
        const long L = (long)i * G + c; if (L >= nwg) return false;
        return at((int)L, u); }
    __host__ __device__ bool at(int wgid, Unit& u) const { { const int q = nwg / NXCD, r = nwg % NXCD, xcd = wgid % NXCD, off = wgid / NXCD; wgid = (xcd < r ? xcd * (q + 1) : r * (q + 1) + (xcd - r) * q) + off; }
        const int nig = WGM * nN, gid = wgid / nig, fm = gid * WGM, gsz = (nM - fm) < WGM ? (nM - fm) : WGM;
        u.pm = fm + ((wgid % nig) % gsz); u.pn = (wgid % nig) / gsz; u.k0 = 0; u.nt = ntk; u.kind = 0; return true;
    }
    __device__ __forceinline__ void a_ready(const Unit&) const {}
    __device__ __forceinline__ void done(const Unit&) const {}
};
struct SplitOrder {
    StaticOrder so; int np, parts, ntp, nsub;
    __host__ __device__ void init(int N, int G_, int c_, int K, int parts_) { so.init(8192, N, G_, c_, K); np = so.nwg; parts = parts_; ntp = K / BK / parts_; nsub = so.nN * parts_; }
    __host__ __device__ bool next(int i, Unit& u) const {
        const long L = (long)i * so.G + so.c; if (L < np) return so.at((int)L, u);
        const int j = (int)(L - np); if (j >= nsub) return false;
        u.pm = 32; u.pn = j % so.nN; u.k0 = (j / so.nN) * ntp * BK; u.nt = ntp; u.kind = 1; return true;
    }
    __device__ __forceinline__ void a_ready(const Unit&) const {}
    __device__ __forceinline__ void done(const Unit&) const {}
};
__device__ __forceinline__ unsigned cvt_pk_bf16(float lo, float hi) { unsigned r; asm volatile("v_cvt_pk_bf16_f32 %0, %1, %2" : "=v"(r) : "v"(lo), "v"(hi)); return r; }
typedef float f32x2 __attribute__((ext_vector_type(2)));


typedef unsigned u32x2 __attribute__((ext_vector_type(2)));
struct EpiZ {
    static constexpr bool PERM = true, AFTER_DRAIN = false;
    bf16_t* Z; int ldz; const float* ssq;
    __device__ __forceinline__ void operator()(const f32x4 (&acc)[2][2][4][2], const Unit& u, int wr, int wc, int fr, int fq) const {
        const int row0 = u.pm * BM + wr * 64 + fr, col0 = u.pn * BM + wc * 32 + 8 * fq;
#pragma unroll
        for (int ai = 0; ai < 2; ++ai)
#pragma unroll
            for (int m = 0; m < 4; ++m) { const int r = row0 + ai * HALF + m * 16; const float rs = rsqrtf(ssq[r] * (1.0f / 2048.0f) + 1e-6f);
                bf16_t* rowp = Z + (size_t)r * ldz + col0;
#pragma unroll
                for (int bj = 0; bj < 2; ++bj) { const f32x4 v0 = acc[ai][bj][m][0] * rs, v1 = acc[ai][bj][m][1] * rs;
                    u32x4 w; w.x = cvt_pk_bf16(v0[0], v0[1]); w.y = cvt_pk_bf16(v0[2], v0[3]); w.z = cvt_pk_bf16(v1[0], v1[1]); w.w = cvt_pk_bf16(v1[2], v1[3]);
                    *(u32x4*)(rowp + bj * HALF) = w; } }
    }
};
struct EpiGU {
    static constexpr bool PERM = true, AFTER_DRAIN = false;
    bf16_t* ACT; int lda; const float* ssq;
    __device__ __forceinline__ void operator()(const f32x4 (&acc)[2][2][4][2], const Unit& u, int wr, int wc, int fr, int fq) const {
        const int row0 = u.pm * BM + wr * 64 + fr, j0 = u.pn * HALF + wc * 32 + 8 * fq;
#pragma unroll
        for (int ai = 0; ai < 2; ++ai)
#pragma unroll
            for (int m = 0; m < 4; ++m) { const int r = row0 + ai * HALF + m * 16; const float rs = rsqrtf(ssq[r] * (1.0f / 2048.0f) + 1e-6f);
                float o[8];
#pragma unroll
                for (int n = 0; n < 2; ++n)
#pragma unroll
                    for (int e = 0; e < 4; ++e) { const float g = acc[ai][0][m][n][e] * rs, uu = acc[ai][1][m][n][e] * rs; o[n * 4 + e] = g * __builtin_amdgcn_rcpf(1.0f + __expf(-g)) * uu; }
                u32x4 w; w.x = cvt_pk_bf16(o[0], o[1]); w.y = cvt_pk_bf16(o[2], o[3]); w.z = cvt_pk_bf16(o[4], o[5]); w.w = cvt_pk_bf16(o[6], o[7]);
                *(u32x4*)(ACT + (size_t)r * lda + j0) = w; }
    }
};
template <int PARTS> struct EpiRes {
    static constexpr bool PERM = false, AFTER_DRAIN = false;
    float* X; bf16_t* XB; float* ssq; unsigned* cnt; int parts; float* part;
    __device__ __forceinline__ void operator()(const f32x4 (&acc)[2][2][4][2], const Unit& u, int wr, int wc, int fr, int fq) const {
        if (u.kind == 0) {
            const int row0 = u.pm * BM + wr * 64 + fr, col0 = u.pn * BM + wc * 32 + 4 * fq;
#pragma unroll
            for (int ai = 0; ai < 2; ++ai)
#pragma unroll
                for (int m = 0; m < 4; ++m) { const int r = row0 + ai * HALF + m * 16; float ss = 0.f;
                    bf16_t* xb = XB + (size_t)r * 2048 + col0;
#pragma unroll
                    for (int bj = 0; bj < 2; ++bj)
#pragma unroll
                        for (int n = 0; n < 2; ++n) { const u32x2 xo = *(const u32x2*)(xb + bj * HALF + n * 16);
                            const f32x4 o = (f32x4){__uint_as_float(xo.x << 16), __uint_as_float(xo.x & 0xffff0000u), __uint_as_float(xo.y << 16), __uint_as_float(xo.y & 0xffff0000u)} + acc[ai][bj][m][n];
                            u32x2 w; w.x = cvt_pk_bf16(o[0], o[1]); w.y = cvt_pk_bf16(o[2], o[3]); *(u32x2*)(xb + bj * HALF + n * 16) = w;
                            ss += (o[0] * o[0] + o[1] * o[1]) + (o[2] * o[2] + o[3] * o[3]); }
                    ss += __shfl_xor(ss, 16); ss += __shfl_xor(ss, 32);
                    if (fq == 0) unsafeAtomicAdd(ssq + r, ss);
                    if (m == 3) asm volatile("" ::: "memory"); }
        } else {
            const int kp = u.k0 / (u.nt * BK); float* P = part + (size_t)kp * 128 * 2048;
            const int rl0 = wr * 64 + fr, col0 = u.pn * BM + wc * 32 + 4 * fq;
#pragma unroll
            for (int m = 0; m < 4; ++m) { float* pr = P + (size_t)(rl0 + m * 16) * 2048 + col0;
#pragma unroll
                for (int bj = 0; bj < 2; ++bj)
#pragma unroll
                    for (int n = 0; n < 2; ++n) { const f32x4 v = acc[0][bj][m][n]; float* q = pr + bj * HALF + n * 16;
                        asm volatile("global_store_dwordx4 %0, %1, off sc1" :: "v"(q), "v"(v) : "memory"); } }
            asm volatile("s_waitcnt vmcnt(0)" ::: "memory");
            const int lane = (int)(threadIdx.x & 63);
            unsigned old = 0u;
            if (lane == 0) old = __hip_atomic_fetch_add(cnt + (u.pn * 8 + wr * 4 + wc), 1u, __ATOMIC_RELAXED, __HIP_MEMORY_SCOPE_AGENT);
            old = (unsigned)__builtin_amdgcn_readfirstlane((int)old);
            if (old == (unsigned)(parts - 1)) {
                __builtin_amdgcn_fence(__ATOMIC_ACQUIRE, "agent"); asm volatile("s_waitcnt vmcnt(0)" ::: "memory");
                const int c4 = (lane & 7) * 4, rg = lane >> 3;
                constexpr int NS = PARTS > 6 ? 1 : 2;
#pragma unroll 1
                for (int rs = 0; rs < 8; ++rs) { const int rl = wr * 64 + rs * 8 + rg; float ss = 0.f;
#pragma unroll 1
                    for (int b0 = 0; b0 < 2; b0 += NS) { f32x4 pv[NS][PARTS + 1];
#pragma unroll
                        for (int bb = 0; bb < NS; ++bb) { const size_t co = (size_t)u.pn * BM + (b0 + bb) * HALF + wc * 32 + c4;
                            pv[bb][PARTS] = *(const f32x4*)(X + (size_t)(8192 + rl) * 2048 + co);
#pragma unroll
                            for (int k = 0; k < PARTS; ++k) pv[bb][k] = *(const f32x4*)(part + ((size_t)k * 128 + rl) * 2048 + co); }
#pragma unroll
                        for (int bb = 0; bb < NS; ++bb) { const size_t xo = (size_t)(8192 + rl) * 2048 + (size_t)u.pn * BM + (b0 + bb) * HALF + wc * 32 + c4; f32x4 o = pv[bb][PARTS];
#pragma unroll
                            for (int k = 0; k < PARTS; ++k) o += pv[bb][k];
                            *(f32x4*)(X + xo) = o; u32x2 w; w.x = cvt_pk_bf16(o[0], o[1]); w.y = cvt_pk_bf16(o[2], o[3]); *(u32x2*)(XB + xo) = w;
                            ss += (o[0] * o[0] + o[1] * o[1]) + (o[2] * o[2] + o[3] * o[3]); } }
                    ss += __shfl_xor(ss, 1); ss += __shfl_xor(ss, 2); ss += __shfl_xor(ss, 4);
                    if ((lane & 7) == 0) unsafeAtomicAdd(ssq + 8192 + rl, ss); }
            }
        }
    }
};

template <class Epi, class Sched, bool ALIGN_EPI = false, bool SP2 = false>
__device__ __forceinline__ void gemm_phase(PG8_LAS unsigned char* lds, const Gemm g, const Sched& S, const Epi& E) {
    int tid_ = threadIdx.x; asm volatile("" : "+v"(tid_));
    const int tid = tid_, wid = __builtin_amdgcn_readfirstlane(tid >> 6), lane = tid & 63, wr = wid >> 2, wc = wid & 3, fr = lane & 15, fq = lane >> 4;
    const int K = g.K;
    unsigned voffA[2], voffB[2];
#pragma unroll
    for (int i = 0; i < 2; ++i) { int R, C; stage_rc(tid * 16 + i * 8192, R, C); const int Rb = Epi::PERM ? ((R & ~31) + perm32(R & 31)) : R;
        voffA[i] = (unsigned)(R * K + C) * 2u; voffB[i] = (unsigned)(Rb * K + C) * 2u; }
    const size_t kstep = (size_t)(BK * 2);
    const size_t hstep = (size_t)HALF * K * 2;
    const size_t tstep = 2 * hstep;
    const unsigned ldsw = (unsigned)wid * 1024u;
    const int aoff = lds_byte(wr * 64 + fr, fq * 8), boff = lds_byte(wc * 32 + fr, fq * 8);
#define PG8_SA(b, h) (((b) * 2 + (h)) * HTB)
#define PG8_SB(b, h) ((4 + (b) * 2 + (h)) * HTB)
#define PG8_STAGE(bufoff, gbase, voff) do { _Pragma("unroll") for (int _i = 0; _i < 2; ++_i) \
        __builtin_amdgcn_global_load_lds((const unsigned*)((const char*)(gbase) + (voff)[_i]), (PG8_LAS unsigned*)(lds + (bufoff) + ldsw + _i * 8192), 16, 0, 0); } while (0)
#define PG8_LDA(dst, b, h) do { _Pragma("unroll") for (int m = 0; m < 4; ++m) _Pragma("unroll") for (int k = 0; k < 2; ++k) dst[m][k] = *(const PG8_LAS bf16x8*)(lds + PG8_SA(b, h) + aoff + m * 2048 + k * 1024); } while (0)
#define PG8_LDB(dst, b, h) do { _Pragma("unroll") for (int n = 0; n < 2; ++n) _Pragma("unroll") for (int k = 0; k < 2; ++k) dst[n][k] = *(const PG8_LAS bf16x8*)(lds + PG8_SB(b, h) + boff + n * 2048 + k * 1024); } while (0)
#define PG8_MMA(ai, bj, At, Bt) do { __builtin_amdgcn_s_setprio(1); _Pragma("unroll") for (int m = 0; m < 4; ++m) _Pragma("unroll") for (int n = 0; n < 2; ++n) _Pragma("unroll") for (int k = 0; k < 2; ++k) \
        acc[ai][bj][m][n] = __builtin_amdgcn_mfma_f32_16x16x32_bf16(Bt[n][k], At[m][k], acc[ai][bj][m][n], 0, 0, 0); __builtin_amdgcn_s_setprio(0); } while (0)
#define PG8_WAIT_V(n) asm volatile("s_waitcnt vmcnt(" #n ")" ::: "memory")
#define PG8_WAIT_L(n) asm volatile("s_waitcnt lgkmcnt(" #n ")" ::: "memory")
#define PG8_BAR __builtin_amdgcn_s_barrier()
#define PG8_SCHED __builtin_amdgcn_sched_barrier(0)
    Unit cur, nxt; int ui = 0;
    if (!S.next(0, cur)) return;
    f32x4 acc[2][2][4][2];
#pragma unroll
    for (int a = 0; a < 2; ++a)
#pragma unroll
        for (int b = 0; b < 2; ++b)
#pragma unroll
            for (int m = 0; m < 4; ++m)
#pragma unroll
                for (int n = 0; n < 2; ++n) acc[a][b][m][n] = (f32x4){0.f, 0.f, 0.f, 0.f};
    bf16x8 At[4][2], B0[2][2], B1[2][2];
    const char* cA = (const char*)g.A + (size_t)cur.pm * tstep + (size_t)cur.k0 * 2; const char* cB = (const char*)g.Bt + (size_t)cur.pn * tstep + (size_t)cur.k0 * 2;
    S.a_ready(cur);
    if constexpr (SP2) {
        PG8_STAGE(PG8_SB(0, 0), cB, voffB); PG8_STAGE(PG8_SB(0, 1), cB + hstep, voffB); PG8_STAGE(PG8_SA(0, 0), cA, voffA); PG8_STAGE(PG8_SA(0, 1), cA + hstep, voffA);
        if (wr == 1) PG8_BAR;
        PG8_WAIT_V(2); PG8_BAR;
        PG8_STAGE(PG8_SB(1, 0), cB + kstep, voffB); PG8_STAGE(PG8_SA(1, 0), cA + kstep, voffA); PG8_STAGE(PG8_SB(1, 1), cB + hstep + kstep, voffB);
        PG8_WAIT_V(6); PG8_BAR;
    } else {
        PG8_STAGE(PG8_SB(0, 0), cB, voffB); PG8_STAGE(PG8_SA(0, 0), cA, voffA); PG8_STAGE(PG8_SB(0, 1), cB + hstep, voffB); PG8_STAGE(PG8_SA(0, 1), cA + hstep, voffA);
        if (wr == 1) PG8_BAR;
        PG8_WAIT_V(4); PG8_BAR;
        PG8_STAGE(PG8_SB(1, 0), cB + kstep, voffB); PG8_STAGE(PG8_SA(1, 0), cA + kstep, voffA); PG8_STAGE(PG8_SB(1, 1), cB + hstep + kstep, voffB);
        PG8_WAIT_V(6); PG8_BAR;
    }
    for (;;) {
        const bool has_next = S.next(ui + 1, nxt);
        const char* nA = has_next ? (const char*)g.A + (size_t)nxt.pm * tstep + (size_t)nxt.k0 * 2 : cA; const char* nB = has_next ? (const char*)g.Bt + (size_t)nxt.pn * tstep + (size_t)nxt.k0 * 2 : cB;
        const int nt = cur.nt;
        for (int t = 0; t < nt; t += 2) {
            const bool last = (t == nt - 2);
            const char* a1 = cA + (size_t)(t + 1) * kstep;
            const char* a2 = last ? nA : cA + (size_t)(t + 2) * kstep; const char* b2 = last ? nB : cB + (size_t)(t + 2) * kstep;
            const char* a3 = a2 + kstep; const char* b3 = b2 + kstep;
            if (last && has_next) S.a_ready(nxt);
            if constexpr (SP2) {
            PG8_LDB(B0, 0, 0); PG8_LDB(B1, 0, 1); PG8_SCHED; PG8_LDA(At, 0, 0); PG8_STAGE(PG8_SA(1, 1), a1 + hstep, voffA);
            PG8_WAIT_V(8); PG8_WAIT_L(0); PG8_BAR; PG8_MMA(0, 0, At, B0); PG8_MMA(0, 1, At, B1); PG8_BAR; PG8_SCHED;
            PG8_LDA(At, 0, 1); PG8_STAGE(PG8_SB(0, 0), b2, voffB); PG8_STAGE(PG8_SB(0, 1), b2 + hstep, voffB); PG8_STAGE(PG8_SA(0, 0), a2, voffA);
            PG8_WAIT_V(8); PG8_WAIT_L(0); PG8_BAR; PG8_MMA(1, 0, At, B0); PG8_MMA(1, 1, At, B1); PG8_BAR; PG8_SCHED;
            PG8_LDB(B0, 1, 0); PG8_LDB(B1, 1, 1); PG8_SCHED; PG8_LDA(At, 1, 0); PG8_STAGE(PG8_SA(0, 1), a2 + hstep, voffA);
            PG8_WAIT_V(8); PG8_WAIT_L(0); PG8_BAR; PG8_MMA(0, 0, At, B0); PG8_MMA(0, 1, At, B1); PG8_BAR; PG8_SCHED;
            PG8_LDA(At, 1, 1); PG8_STAGE(PG8_SB(1, 0), b3, voffB); PG8_STAGE(PG8_SB(1, 1), b3 + hstep, voffB); PG8_STAGE(PG8_SA(1, 0), a3, voffA);
            PG8_WAIT_V(8); PG8_WAIT_L(0); PG8_BAR; PG8_MMA(1, 0, At, B0); PG8_MMA(1, 1, At, B1); PG8_BAR; PG8_SCHED;
            } else {
            PG8_LDB(B0, 0, 0); PG8_SCHED; PG8_LDA(At, 0, 0); PG8_STAGE(PG8_SA(1, 1), a1 + hstep, voffA);
            PG8_WAIT_L(8); PG8_BAR; PG8_WAIT_L(0); PG8_MMA(0, 0, At, B0); PG8_BAR; PG8_SCHED;
            PG8_LDB(B1, 0, 1); PG8_STAGE(PG8_SB(0, 0), b2, voffB);
            PG8_BAR; PG8_WAIT_L(0); PG8_MMA(0, 1, At, B1); PG8_BAR;
            PG8_LDA(At, 0, 1); PG8_STAGE(PG8_SA(0, 0), a2, voffA);
            PG8_BAR; PG8_WAIT_L(0); PG8_MMA(1, 0, At, B0); PG8_BAR; PG8_SCHED;
            PG8_STAGE(PG8_SB(0, 1), b2 + hstep, voffB);
            PG8_WAIT_V(6); PG8_BAR; PG8_MMA(1, 1, At, B1); PG8_BAR;
            PG8_LDB(B0, 1, 0); PG8_SCHED; PG8_LDA(At, 1, 0); PG8_STAGE(PG8_SA(0, 1), a2 + hstep, voffA);
            PG8_WAIT_L(8); PG8_BAR; PG8_WAIT_L(0); PG8_MMA(0, 0, At, B0); PG8_BAR; PG8_SCHED;
            PG8_LDB(B1, 1, 1); PG8_STAGE(PG8_SB(1, 0), b3, voffB);
            PG8_BAR; PG8_WAIT_L(0); PG8_MMA(0, 1, At, B1); PG8_BAR;
            PG8_LDA(At, 1, 1); PG8_STAGE(PG8_SA(1, 0), a3, voffA);
            PG8_BAR; PG8_WAIT_L(0); PG8_MMA(1, 0, At, B0); PG8_BAR; PG8_SCHED;
            PG8_STAGE(PG8_SB(1, 1), b3 + hstep, voffB);
            PG8_WAIT_V(6); PG8_BAR; PG8_MMA(1, 1, At, B1); PG8_BAR;
            }
        }
        if constexpr (ALIGN_EPI) { if (wr == 0) PG8_BAR; }
        if constexpr (!Epi::AFTER_DRAIN) { E(acc, cur, wr, wc, fr, fq); S.done(cur); }
        if (!has_next) break;
#pragma unroll
        for (int a = 0; a < 2; ++a)
#pragma unroll
            for (int b = 0; b < 2; ++b)
#pragma unroll
                for (int m = 0; m < 4; ++m)
#pragma unroll
                    for (int n = 0; n < 2; ++n) acc[a][b][m][n] = (f32x4){0.f, 0.f, 0.f, 0.f};
        cur = nxt; cA = nA; cB = nB; ++ui;
        if constexpr (ALIGN_EPI) { if (wr == 1) PG8_BAR; }
    }
    PG8_WAIT_V(0);
    if constexpr (!ALIGN_EPI) { if (wr == 0) PG8_BAR; }
    PG8_BAR;
    if constexpr (Epi::AFTER_DRAIN) { E.fused(acc, cur, wr, wc, fr, fq, lds, wid, lane); S.done(cur); }
#undef PG8_SA
#undef PG8_SB
#undef PG8_STAGE
#undef PG8_LDA
#undef PG8_LDB
#undef PG8_MMA
#undef PG8_WAIT_V
#undef PG8_WAIT_L
#undef PG8_BAR
#undef PG8_SCHED
}
}


#define LAS __attribute__((address_space(3)))
typedef unsigned short bf16;
typedef float f32x4 __attribute__((ext_vector_type(4)));
typedef float f32x2 __attribute__((ext_vector_type(2)));
typedef unsigned u32x4 __attribute__((ext_vector_type(4)));
typedef unsigned u32x2 __attribute__((ext_vector_type(2)));
constexpr int LDS_BYTES = 147456;
constexpr size_t MiB = 1u << 20;
constexpr size_t WS_SSQ = 0, WS_DEC = 256 * 1024, WS_BAR = 512 * 1024, WS_CNT = 640 * 1024, WS_XB = 1 * MiB, WS_MIX = 34 * MiB, WS_ZACT = 67 * MiB, WS_DS = 158 * MiB, WS_VD = 174 * MiB, WS_W = 182 * MiB;
constexpr size_t WL_IN = 0, WL_O = 21 * MiB, WL_GU = 29 * MiB, WL_D = 73 * MiB, WL_BYTES = 95 * MiB, WL_D1 = 95 * MiB, WS_PART = WS_W + WL_BYTES + 22 * MiB, WS_BB = WS_PART + 12 * MiB, WS_END = WS_BB + 8 * MiB;
static_assert((size_t)MP * DM * 2 <= 33 * MiB && (size_t)MP * DFF * 2 <= 91 * MiB && (size_t)NINP * DM * 2 <= 21 * MiB && (size_t)2 * DFF * DM * 2 <= 44 * MiB && (size_t)DM * DFF * 2 <= 22 * MiB, "ws map");
constexpr size_t O_Y = 0, O_CAP = 17039360, O_CAS = 17047552, O_GP = 17309696, O_GS = 17571840, O_CCP = 25960448, O_CCS = 26083328, O_SVP = 30015488, O_SVS = 30539776;
enum { I_XP = 0, I_XS, I_SCA, I_SGLA, I_SCC, I_NMIX, I_WIN, I_CAW, I_A2, I_ABIAS, I_GNORM, I_CCW, I_CCB, I_LNCG, I_LNCB, I_LNDG, I_LNDB, I_SGW, I_SGB, I_WO, I_NFFN, I_WG, I_WU, I_WD, I_NFIN };
struct Args { const float* in[25]; float* out; unsigned char* ws; int pad0, pad1; };
typedef const __attribute__((address_space(4))) Args* CA;
__device__ __forceinline__ CA fresh_args() { CA p = (CA)__builtin_amdgcn_kernarg_segment_ptr(); asm volatile("" : "+s"(p)); return p; }

__device__ __forceinline__ float bflo(unsigned w) { return __uint_as_float(w << 16); }
__device__ __forceinline__ float bfhi(unsigned w) { return __uint_as_float(w & 0xffff0000u); }
__device__ __forceinline__ float bf2f(bf16 v) { return __uint_as_float((unsigned)v << 16); }
__device__ __forceinline__ unsigned pk2(float lo, float hi) { return pg8::cvt_pk_bf16(lo, hi); }
__device__ __forceinline__ void ld8(const bf16* p, float (&v)[8]) { const u32x4 w = *(const u32x4*)p; v[0] = bflo(w.x); v[1] = bfhi(w.x); v[2] = bflo(w.y); v[3] = bfhi(w.y); v[4] = bflo(w.z); v[5] = bfhi(w.z); v[6] = bflo(w.w); v[7] = bfhi(w.w); }
__device__ __forceinline__ void up8(const u32x4 w, float (&v)[8]) { v[0] = bflo(w.x); v[1] = bfhi(w.x); v[2] = bflo(w.y); v[3] = bfhi(w.y); v[4] = bflo(w.z); v[5] = bfhi(w.z); v[6] = bflo(w.w); v[7] = bfhi(w.w); }
__device__ __forceinline__ void ld4(const bf16* p, float (&v)[4]) { const u32x2 w = *(const u32x2*)p; v[0] = bflo(w.x); v[1] = bfhi(w.x); v[2] = bflo(w.y); v[3] = bfhi(w.y); }
__device__ __forceinline__ void st8(bf16* p, const float (&v)[8]) { u32x4 w; w.x = pk2(v[0], v[1]); w.y = pk2(v[2], v[3]); w.z = pk2(v[4], v[5]); w.w = pk2(v[6], v[7]); *(u32x4*)p = w; }
__device__ __forceinline__ void ldf8(const float* p, float (&v)[8]) { const f32x4 a = *(const f32x4*)p, b = *(const f32x4*)(p + 4); v[0] = a[0]; v[1] = a[1]; v[2] = a[2]; v[3] = a[3]; v[4] = b[0]; v[5] = b[1]; v[6] = b[2]; v[7] = b[3]; }
__device__ __forceinline__ void stf8(float* p, const float (&v)[8]) { *(f32x4*)p = (f32x4){v[0], v[1], v[2], v[3]}; *(f32x4*)(p + 4) = (f32x4){v[4], v[5], v[6], v[7]}; }
__device__ __forceinline__ float wave_sum(float v) {
#pragma unroll
    for (int o = 1; o < 64; o <<= 1) v += __shfl_xor(v, o);
    return v; }
__device__ __forceinline__ float sigmf(float x) { return __builtin_amdgcn_rcpf(1.0f + __expf(-x)); }
__device__ __forceinline__ float siluf(float x) { return x * __builtin_amdgcn_rcpf(1.0f + __expf(-x)); }
__device__ __forceinline__ float geluf(float x) { const float y = 0.7978845608028654f * (x + 0.044715f * x * x * x); const float t = 1.0f - 2.0f * __builtin_amdgcn_rcpf(__expf(2.0f * y) + 1.0f); return 0.5f * x * (1.0f + t); }
__device__ __forceinline__ float logsigf(float x) { return fminf(x, 0.f) - __logf(1.0f + __expf(-fabsf(x))); }
#define LDS_WAIT() asm volatile("s_waitcnt lgkmcnt(0)" ::: "memory")

__device__ __forceinline__ void tr_item(const float* W, int ldw, int nvalid, const float* gain, bf16* WT, int K, int dst_row0, int k0, int n0, LAS float* scr, int lane) {
    const int nq = (lane & 15) * 4, kr = lane >> 4; const bool ok = (n0 + nq) < nvalid;
    f32x4 v[16];
    const float* src = W + (size_t)(k0 + kr) * ldw + n0 + nq;
#pragma unroll
    for (int i = 0; i < 16; ++i) v[i] = ok ? __builtin_nontemporal_load((const f32x4*)(src + (size_t)(4 * i) * ldw)) : (f32x4){0.f, 0.f, 0.f, 0.f};
    if (gain) {
#pragma unroll
        for (int i = 0; i < 16; ++i) v[i] *= gain[k0 + 4 * i + kr]; }
#pragma unroll
    for (int i = 0; i < 16; ++i) { LAS float* d = scr + (4 * i + kr) * 65 + nq; d[0] = v[i][0]; d[1] = v[i][1]; d[2] = v[i][2]; d[3] = v[i][3]; }
    LDS_WAIT(); asm volatile("" ::: "memory");
    const int c = lane >> 3, nn0 = lane & 7;
#pragma unroll
    for (int j = 0; j < 8; ++j) { const int nn = nn0 + 8 * j; const LAS float* s = scr + (8 * c) * 65 + nn;
        u32x4 o; o.x = pk2(s[0 * 65], s[1 * 65]); o.y = pk2(s[2 * 65], s[3 * 65]); o.z = pk2(s[4 * 65], s[5 * 65]); o.w = pk2(s[6 * 65], s[7 * 65]);
        __builtin_nontemporal_store(o, (u32x4*)(WT + (size_t)(dst_row0 + nn) * K + k0 + 8 * c)); }
    LDS_WAIT(); asm volatile("" ::: "memory");
}
__device__ __forceinline__ void p0_prologue(CA a, int l, LAS unsigned char* lds, int gw, int NGW, int wave, int lane) {
    LAS float* scr = (LAS float*)(lds + wave * 16640);
    unsigned char* ws = a->ws;
    constexpr int I_IN = 32 * 84, I_O = 32 * 32, I_G = 32 * 88, I_D = 88 * 32, PER_L = I_IN + I_O + 2 * I_G + I_D;
    unsigned char* wl = ws + WS_W;
    for (int it = gw; it < PER_L; it += NGW) {
        int r = it;
        if (r < I_IN) { const int kb = r / 84, nb = r % 84; tr_item(a->in[I_WIN] + (size_t)l * DM * NIN, NIN, NIN, a->in[I_NMIX] + l * DM, (bf16*)(wl + WL_IN), DM, 64 * nb, 64 * kb, 64 * nb, scr, lane); continue; } r -= I_IN;
        if (r < I_O) { const int kb = r / 32, nb = r % 32; tr_item(a->in[I_WO] + (size_t)l * DM * DM, DM, DM, nullptr, (bf16*)(wl + WL_O), DM, 64 * nb, 64 * kb, 64 * nb, scr, lane); continue; } r -= I_O;
        if (r < I_G) { const int kb = r / 88, nb = r % 88, n0 = 64 * nb; tr_item(a->in[I_WG] + (size_t)l * DM * DFF, DFF, DFF, a->in[I_NFFN] + l * DM, (bf16*)(wl + WL_GU), DM, (n0 >> 7) * 256 + (n0 & 127), 64 * kb, n0, scr, lane); continue; } r -= I_G;
        if (r < I_G) { const int kb = r / 88, nb = r % 88, n0 = 64 * nb; tr_item(a->in[I_WU] + (size_t)l * DM * DFF, DFF, DFF, a->in[I_NFFN] + l * DM, (bf16*)(wl + WL_GU), DM, (n0 >> 7) * 256 + 128 + (n0 & 127), 64 * kb, n0, scr, lane); continue; } r -= I_G;
        { const int kb = r / 32, nb = r % 32; tr_item(a->in[I_WD] + (size_t)l * DFF * DM, DM, DM, nullptr, (bf16*)(wl + (l ? WL_D1 : WL_D)), DFF, 64 * nb, 64 * kb, 64 * nb, scr, lane); }
    }
    if (l != 0) return;
    float* X = a->out + O_Y; bf16* XB = (bf16*)(ws + WS_XB); float* ssq = (float*)(ws + WS_SSQ);
    for (int r0 = gw * 2; r0 < MP; r0 += NGW * 2) {
        f32x4 v[2][8];
#pragma unroll
        for (int q = 0; q < 2; ++q) { const int r = r0 + q; const float* src = r < NPROMPT ? a->in[I_XP] + (size_t)r * DM : a->in[I_XS] + (size_t)(r - NPROMPT) * DM;
#pragma unroll
            for (int j = 0; j < 8; ++j) v[q][j] = r < MR ? *(const f32x4*)(src + 256 * j + 4 * lane) : (f32x4){0.f, 0.f, 0.f, 0.f}; }
#pragma unroll
        for (int q = 0; q < 2; ++q) { const int r = r0 + q; float ss = 0.f;
#pragma unroll
            for (int j = 0; j < 8; ++j) { const f32x4 x = v[q][j]; if (r >= NPROMPT && r < MR) *(f32x4*)(X + (size_t)r * DM + 256 * j + 4 * lane) = x;
                u32x2 w; w.x = pk2(x[0], x[1]); w.y = pk2(x[2], x[3]); *(u32x2*)(XB + (size_t)r * DM + 256 * j + 4 * lane) = w;
                ss += (x[0] * x[0] + x[1] * x[1]) + (x[2] * x[2] + x[3] * x[3]); }
            ss = wave_sum(ss);
            if (lane < 5) ssq[lane * MP + r] = lane == 0 ? ss : 0.f; }
    }
}

constexpr int OFF_B = 0, OFF_QT = 4160, OFF_KT = 8512, OFF_AT = 12864, OFF_V = 17216, OFF_S = 25408;
__device__ __forceinline__ void gla_b(CA a, int l, const bf16* Z, int row0, int h, LAS float* Bm, LAS float* G, int tid) {
    LAS float* glr = G; LAS float* A2h = G + 1024; LAS float* bia = G + 2048; LAS float* seg = G + 2112;
    for (int e = tid; e < 1024; e += 512) { const int i = e >> 4, r = e & 15; glr[e] = bf2f(Z[(size_t)(row0 + i) * NINP + ZLR + r]); }
    for (int e = tid; e < 1024; e += 512) { const int r = e >> 6, d = e & 63; A2h[e] = a->in[I_A2][(l * 16 + r) * 256 + h * 64 + d]; }
    if (tid < 64) bia[tid] = a->in[I_ABIAS][l * 256 + h * 64 + tid];
    __syncthreads();
    { const int i = tid >> 3, d0 = (tid & 7) * 8; float acc[8];
#pragma unroll
        for (int e = 0; e < 8; ++e) acc[e] = bia[d0 + e];
#pragma unroll
        for (int r = 0; r < 16; ++r) { const float g = glr[i * 16 + r];
#pragma unroll
            for (int e = 0; e < 8; ++e) acc[e] += g * A2h[r * 64 + d0 + e]; }
#pragma unroll
        for (int e = 0; e < 8; ++e) Bm[i * 65 + d0 + e] = logsigf(acc[e]) * (1.0f / 16.0f); }
    __syncthreads();
    const int sg = tid >> 6, d = tid & 63;
    { float run = 0.f;
#pragma unroll
        for (int k = 0; k < 8; ++k) { run += Bm[(sg * 8 + k) * 65 + d]; Bm[(sg * 8 + k) * 65 + d] = run; }
        seg[sg * 64 + d] = run; }
    __syncthreads();
    { float pre = 0.f;
#pragma unroll
        for (int s = 0; s < 7; ++s) if (s < sg) pre += seg[s * 64 + d];
#pragma unroll
        for (int k = 0; k < 8; ++k) Bm[(sg * 8 + k) * 65 + d] += pre; }
    __syncthreads();
}

typedef short mf_bf16x8 __attribute__((ext_vector_type(8)));
__device__ __forceinline__ void p2_gla_ds(CA a, int l, int it, LAS unsigned char* lds, int tid) {
    a = fresh_args();
    const int b = it >> 7, c = (it >> 2) & 31, h = it & 3, row0 = b * SEQ + c * 64;
    const bf16* Z = (const bf16*)(a->ws + WS_ZACT);
    LAS float* L = (LAS float*)lds; LAS float* Bm = L; LAS float* G = L + 4160;
    LAS bf16* KPt = (LAS bf16*)(L + 4160 + 4224); LAS bf16* Vt = KPt + 64 * 72;
    __syncthreads();
    gla_b(a, l, Z, row0, h, Bm, G, tid);
    { const int i = tid >> 3, d0 = (tid & 7) * 8; float* bb = (float*)(a->ws + WS_BB) + (size_t)it * 4096 + i * 64 + d0;
        *(f32x4*)bb = (f32x4){Bm[i * 65 + d0], Bm[i * 65 + d0 + 1], Bm[i * 65 + d0 + 2], Bm[i * 65 + d0 + 3]}; *(f32x4*)(bb + 4) = (f32x4){Bm[i * 65 + d0 + 4], Bm[i * 65 + d0 + 5], Bm[i * 65 + d0 + 6], Bm[i * 65 + d0 + 7]}; }
    { const int j = tid & 63, dg = tid >> 6; float kv[8]; ld8(Z + (size_t)(row0 + j) * NINP + ZK + h * 64 + dg * 8, kv);
#pragma unroll
        for (int e = 0; e < 8; ++e) { const int d = dg * 8 + e; KPt[d * 72 + j] = (bf16)(pk2(kv[e] * __expf(Bm[63 * 65 + d] - Bm[j * 65 + d]), 0.f) & 0xffffu); } }
#pragma unroll
    for (int q = 0; q < 2; ++q) { const int idx = tid + q * 512, j = idx & 63, dv8 = (idx >> 6) * 8; const u32x4 vr = *(const u32x4*)(Z + (size_t)(row0 + j) * NINP + ZV + h * 128 + dv8);
        const unsigned ww[4] = {vr.x, vr.y, vr.z, vr.w};
#pragma unroll
        for (int e = 0; e < 4; ++e) { Vt[(dv8 + 2 * e) * 72 + j] = (bf16)(ww[e] & 0xffffu); Vt[(dv8 + 2 * e + 1) * 72 + j] = (bf16)(ww[e] >> 16); } }
    __syncthreads();
    { const int wv = tid >> 6, lane = tid & 63, fr = lane & 15, fq = lane >> 4, mi = wv >> 1, nh = wv & 1; f32x4 acc[4];
#pragma unroll
        for (int t = 0; t < 4; ++t) acc[t] = (f32x4){0.f, 0.f, 0.f, 0.f};
#pragma unroll
        for (int ks = 0; ks < 2; ++ks) { const mf_bf16x8 af = *(const LAS mf_bf16x8*)(KPt + (16 * mi + fr) * 72 + 32 * ks + 8 * fq);
#pragma unroll
            for (int t = 0; t < 4; ++t) acc[t] = __builtin_amdgcn_mfma_f32_16x16x32_bf16(*(const LAS mf_bf16x8*)(Vt + (16 * (4 * nh + t) + fr) * 72 + 32 * ks + 8 * fq), af, acc[t], 0, 0, 0); }
        float* DS = (float*)(a->ws + WS_DS) + (size_t)it * 8192 + (16 * mi + fr) * 128;
#pragma unroll
        for (int t = 0; t < 4; ++t) *(f32x4*)(DS + 16 * (4 * nh + t) + 4 * fq) = acc[t]; }
    if (tid < 64) ((float*)(a->ws + WS_DEC))[it * 64 + tid] = __expf(Bm[63 * 65 + tid]);
}

__device__ __forceinline__ void p4_gla_o(CA a, int l, int it, LAS unsigned char* lds, int tid) {
    a = fresh_args();
    const int b = it >> 7, c = (it >> 2) & 31, h = it & 3, row0 = b * SEQ + c * 64;
    const bf16* Z = (const bf16*)(a->ws + WS_ZACT); bf16* MIX = (bf16*)(a->ws + WS_MIX);
    LAS float* L = (LAS float*)lds; LAS float* Bm = L; LAS float* G = L + 4160;
    LAS bf16* Qp = (LAS bf16*)(L + 4160 + 4224); LAS bf16* Kp = Qp + 64 * 72; LAS bf16* Vt = Kp + 64 * 72; LAS bf16* St = Vt + 128 * 72; LAS float* SS = (LAS float*)(St + 128 * 72);
    LAS bf16* ATT = (LAS bf16*)G;
    __syncthreads();
    { const int i = tid >> 3, d0 = (tid & 7) * 8; const float* bb = (const float*)(a->ws + WS_BB) + (size_t)it * 4096 + i * 64 + d0; const f32x4 b0 = *(const f32x4*)bb, b1 = *(const f32x4*)(bb + 4);
#pragma unroll
        for (int e = 0; e < 4; ++e) { Bm[i * 65 + d0 + e] = b0[e]; Bm[i * 65 + d0 + 4 + e] = b1[e]; } }
    __syncthreads();
    { const int i = tid & 63, dg = tid >> 6; float qv[8], kv[8];
        ld8(Z + (size_t)(row0 + i) * NINP + ZQ + h * 64 + dg * 8, qv); ld8(Z + (size_t)(row0 + i) * NINP + ZK + h * 64 + dg * 8, kv);
#pragma unroll
        for (int e = 0; e < 8; ++e) { const float bb = Bm[i * 65 + dg * 8 + e]; qv[e] *= 0.125f * __expf(bb); kv[e] *= __expf(-bb); }
        u32x4 w; w.x = pk2(qv[0], qv[1]); w.y = pk2(qv[2], qv[3]); w.z = pk2(qv[4], qv[5]); w.w = pk2(qv[6], qv[7]); *(LAS u32x4*)(Qp + i * 72 + dg * 8) = w;
        w.x = pk2(kv[0], kv[1]); w.y = pk2(kv[2], kv[3]); w.z = pk2(kv[4], kv[5]); w.w = pk2(kv[6], kv[7]); *(LAS u32x4*)(Kp + i * 72 + dg * 8) = w; }
    { u32x4 vr[2]; f32x4 sr[4]; const float* Sg = (const float*)(a->ws + WS_DS) + (size_t)it * 8192;
#pragma unroll
        for (int q = 0; q < 2; ++q) { const int idx = tid + q * 512, j = idx & 63, dv8 = (idx >> 6) * 8; vr[q] = *(const u32x4*)(Z + (size_t)(row0 + j) * NINP + ZV + h * 128 + dv8); }
#pragma unroll
        for (int q = 0; q < 4; ++q) { const int idx = tid + q * 512, d = idx & 63, dv4 = (idx >> 6) * 4; sr[q] = *(const f32x4*)(Sg + d * 128 + dv4); }
#pragma unroll
        for (int q = 0; q < 2; ++q) { const int idx = tid + q * 512, j = idx & 63, dv8 = (idx >> 6) * 8; const unsigned ww[4] = {vr[q].x, vr[q].y, vr[q].z, vr[q].w};
#pragma unroll
            for (int e = 0; e < 4; ++e) { Vt[(dv8 + 2 * e) * 72 + j] = (bf16)(ww[e] & 0xffffu); Vt[(dv8 + 2 * e + 1) * 72 + j] = (bf16)(ww[e] >> 16); } }
#pragma unroll
        for (int q = 0; q < 4; ++q) { const int idx = tid + q * 512, d = idx & 63, dv4 = (idx >> 6) * 4; const unsigned p0 = pk2(sr[q][0], sr[q][1]), p1 = pk2(sr[q][2], sr[q][3]);
            St[(dv4 + 0) * 72 + d] = (bf16)(p0 & 0xffffu); St[(dv4 + 1) * 72 + d] = (bf16)(p0 >> 16); St[(dv4 + 2) * 72 + d] = (bf16)(p1 & 0xffffu); St[(dv4 + 3) * 72 + d] = (bf16)(p1 >> 16); } }
    __syncthreads();
    const int wv = tid >> 6, lane = tid & 63, fr = lane & 15, fq = lane >> 4, mi = wv >> 1, nh = wv & 1;
    {
        const mf_bf16x8 a0 = *(const LAS mf_bf16x8*)(Qp + (16 * mi + fr) * 72 + 8 * fq), a1 = *(const LAS mf_bf16x8*)(Qp + (16 * mi + fr) * 72 + 32 + 8 * fq);
#pragma unroll
        for (int t = 0; t < 2; ++t) { const int nj = 2 * nh + t; f32x4 at = (f32x4){0.f, 0.f, 0.f, 0.f};
            at = __builtin_amdgcn_mfma_f32_16x16x32_bf16(*(const LAS mf_bf16x8*)(Kp + (16 * nj + fr) * 72 + 8 * fq), a0, at, 0, 0, 0);
            at = __builtin_amdgcn_mfma_f32_16x16x32_bf16(*(const LAS mf_bf16x8*)(Kp + (16 * nj + fr) * 72 + 32 + 8 * fq), a1, at, 0, 0, 0);
            const int i = 16 * mi + fr, j0 = 16 * nj + 4 * fq; u32x2 w;
            w.x = pk2(j0 <= i ? at[0] : 0.f, j0 + 1 <= i ? at[1] : 0.f); w.y = pk2(j0 + 2 <= i ? at[2] : 0.f, j0 + 3 <= i ? at[3] : 0.f);
            *(LAS u32x2*)(ATT + i * 72 + j0) = w; } }
    __syncthreads();
    f32x4 acc[4];
#pragma unroll
    for (int t = 0; t < 4; ++t) acc[t] = (f32x4){0.f, 0.f, 0.f, 0.f};
    const int nks1 = mi < 2 ? 1 : 2;
    for (int ks = 0; ks < nks1; ++ks) { const mf_bf16x8 af = *(const LAS mf_bf16x8*)(ATT + (16 * mi + fr) * 72 + 32 * ks + 8 * fq);
#pragma unroll
        for (int t = 0; t < 4; ++t) acc[t] = __builtin_amdgcn_mfma_f32_16x16x32_bf16(*(const LAS mf_bf16x8*)(Vt + (16 * (4 * nh + t) + fr) * 72 + 32 * ks + 8 * fq), af, acc[t], 0, 0, 0); }
#pragma unroll
    for (int ks = 0; ks < 2; ++ks) { const mf_bf16x8 af = *(const LAS mf_bf16x8*)(Qp + (16 * mi + fr) * 72 + 32 * ks + 8 * fq);
#pragma unroll
        for (int t = 0; t < 4; ++t) acc[t] = __builtin_amdgcn_mfma_f32_16x16x32_bf16(*(const LAS mf_bf16x8*)(St + (16 * (4 * nh + t) + fr) * 72 + 32 * ks + 8 * fq), af, acc[t], 0, 0, 0); }
    { float ss = 0.f;
#pragma unroll
        for (int t = 0; t < 4; ++t) ss += (acc[t][0] * acc[t][0] + acc[t][1] * acc[t][1]) + (acc[t][2] * acc[t][2] + acc[t][3] * acc[t][3]);
        ss += __shfl_xor(ss, 16); ss += __shfl_xor(ss, 32);
        if (fq == 0) SS[(16 * mi + fr) * 2 + nh] = ss; }
    __syncthreads();
    { const int i = 16 * mi + fr; const size_t row = (size_t)(row0 + i); const float rs = rsqrtf((SS[i * 2] + SS[i * 2 + 1]) * (1.0f / 128.0f) + EPS);
#pragma unroll
        for (int t = 0; t < 4; ++t) { const int dv = 16 * (4 * nh + t) + 4 * fq; const f32x4 gn = *(const f32x4*)(a->in[I_GNORM] + l * 512 + h * 128 + dv);
            float gr[4]; ld4(Z + row * NINP + ZR + h * 128 + dv, gr);
            u32x2 w; w.x = pk2(acc[t][0] * rs * gn[0] * siluf(gr[0]), acc[t][1] * rs * gn[1] * siluf(gr[1])); w.y = pk2(acc[t][2] * rs * gn[2] * siluf(gr[2]), acc[t][3] * rs * gn[3] * siluf(gr[3]));
            *(u32x2*)(MIX + row * DM + 512 + h * 128 + dv) = w; } }
}

__device__ __forceinline__ void p4_sgu(CA a, int l, int it, LAS unsigned char* lds, int tid) {
    a = fresh_args();
    const int b = it >> 6, n = (it >> 2) & 15, h = it & 3, row0 = b * SEQ + n * 128;
    const bf16* Z = (const bf16*)(a->ws + WS_ZACT); bf16* MIX = (bf16*)(a->ws + WS_MIX); const bf16* VD = (const bf16*)(a->ws + WS_VD);
    LAS bf16* Wb = (LAS bf16*)lds; LAS bf16* Vt = Wb + 128 * 136;
    __syncthreads();
    const float* sgw = a->in[I_SGW] + (size_t)(l * 4 + h) * 128 * 128;
    { f32x4 w[8]; u32x4 vr[4];
#pragma unroll
        for (int q = 0; q < 8; ++q) { const int ch = tid + q * 512, i = ch >> 5, j4 = (ch & 31) * 4; w[q] = *(const f32x4*)(sgw + i * 128 + j4); }
#pragma unroll
        for (int q = 0; q < 4; ++q) { const int ch = tid + q * 512, j = ch & 127, d8 = (ch >> 7) * 8; vr[q] = *(const u32x4*)(VD + (size_t)(row0 + j) * 512 + h * 128 + d8); }
#pragma unroll
        for (int q = 0; q < 8; ++q) { const int ch = tid + q * 512, i = ch >> 5, j4 = (ch & 31) * 4; f32x4 v = w[q];
#pragma unroll
            for (int e = 0; e < 4; ++e) v[e] = (j4 + e <= i) ? v[e] : 0.f;
            u32x2 o; o.x = pk2(v[0], v[1]); o.y = pk2(v[2], v[3]); *(LAS u32x2*)(Wb + i * 136 + j4) = o; }
#pragma unroll
        for (int q = 0; q < 4; ++q) { const int ch = tid + q * 512, j = ch & 127, d8 = (ch >> 7) * 8; const unsigned ww[4] = {vr[q].x, vr[q].y, vr[q].z, vr[q].w};
#pragma unroll
            for (int e = 0; e < 4; ++e) { Vt[(d8 + 2 * e) * 136 + j] = (bf16)(ww[e] & 0xffffu); Vt[(d8 + 2 * e + 1) * 136 + j] = (bf16)(ww[e] >> 16); } } }
    __syncthreads();
    const int wv = tid >> 6, lane = tid & 63, fr = lane & 15, fq = lane >> 4;
    f32x4 acc[8];
#pragma unroll
    for (int nt = 0; nt < 8; ++nt) acc[nt] = (f32x4){0.f, 0.f, 0.f, 0.f};
    const int nks = (16 * wv + 15) / 32 + 1;
    for (int ks = 0; ks < nks; ++ks) { const mf_bf16x8 af = *(const LAS mf_bf16x8*)(Wb + (16 * wv + fr) * 136 + 32 * ks + 8 * fq);
#pragma unroll
        for (int nt = 0; nt < 8; ++nt) { const mf_bf16x8 bfr = *(const LAS mf_bf16x8*)(Vt + (16 * nt + fr) * 136 + 32 * ks + 8 * fq);
            acc[nt] = __builtin_amdgcn_mfma_f32_16x16x32_bf16(bfr, af, acc[nt], 0, 0, 0); } }
    { const int i = 16 * wv + fr; const size_t row = (size_t)(row0 + i); const float bs = a->in[I_SGB][(l * 4 + h) * 128 + i];
#pragma unroll
        for (int nt = 0; nt < 8; ++nt) { const int d = 16 * nt + 4 * fq; float up[4]; ld4(Z + row * NINP + ZD + h * 128 + d, up);
            u32x2 o; o.x = pk2(geluf(up[0]) * (acc[nt][0] + bs), geluf(up[1]) * (acc[nt][1] + bs)); o.y = pk2(geluf(up[2]) * (acc[nt][2] + bs), geluf(up[3]) * (acc[nt][3] + bs));
            *(u32x2*)(MIX + row * DM + 1536 + h * 128 + d) = o; } }
}

__device__ __forceinline__ void p2_conf(CA a, int l, int it, LAS unsigned char* lds, int tid, int wave, int lane) {
    a = fresh_args();
    const int b = it >> 6, tile = it & 63, t0 = tile * 32;
    const bf16* Z = (const bf16*)(a->ws + WS_ZACT); bf16* MIX = (bf16*)(a->ws + WS_MIX);
    LAS float* CIN = (LAS float*)lds;
    float w[31]; const float* cw = a->in[I_CCW] + (size_t)l * 31 * 512 + tid;
#pragma unroll
    for (int j = 0; j < 31; ++j) w[j] = cw[j * 512];
    const float bsv = a->in[I_CCB][l * 512 + tid];
    __syncthreads();
    { const int rr = tid >> 6, c8 = (tid & 63) * 8; u32x4 ga[8], gb[8];
#pragma unroll
        for (int p = 0; p < 8; ++p) { const int i = p * 8 + rr, t = t0 - 30 + i; ga[p] = (u32x4){0u, 0u, 0u, 0u}; gb[p] = ga[p];
            if (i < 62 && t >= 0) { const bf16* zr = Z + (size_t)(b * SEQ + t) * NINP + ZC + c8; ga[p] = *(const u32x4*)zr; gb[p] = *(const u32x4*)(zr + 512); } }
#pragma unroll
        for (int p = 0; p < 8; ++p) { const int i = p * 8 + rr; if (i < 62) { float fa[8], fb[8], cv[8]; up8(ga[p], fa); up8(gb[p], fb);
#pragma unroll
                for (int e = 0; e < 8; ++e) cv[e] = fa[e] * sigmf(fb[e]);
                *(LAS f32x4*)(CIN + i * 512 + c8) = (f32x4){cv[0], cv[1], cv[2], cv[3]}; *(LAS f32x4*)(CIN + i * 512 + c8 + 4) = (f32x4){cv[4], cv[5], cv[6], cv[7]};
                if (tile == 63 && i >= 32) stf8(a->out + O_CCP + ((size_t)(l * 4 + b) * 30 + (i - 32)) * 512 + c8, cv); } } }
    __syncthreads();
    { const int c = tid; float acc[32];
#pragma unroll
        for (int t = 0; t < 32; ++t) acc[t] = bsv;
#pragma unroll
        for (int i = 0; i < 62; ++i) { const float v = CIN[i * 512 + c];
#pragma unroll
            for (int t = 0; t < 32; ++t) { if (i - t >= 0 && i - t <= 30) acc[t] += w[i - t] * v; } }
        __syncthreads();
#pragma unroll
        for (int t = 0; t < 32; ++t) CIN[t * 512 + c] = acc[t]; }
    __syncthreads();
    { float g[8], bt[8]; ldf8(a->in[I_LNCG] + l * 512 + lane * 8, g); ldf8(a->in[I_LNCB] + l * 512 + lane * 8, bt);
#pragma unroll
        for (int rr = 0; rr < 4; ++rr) { const int t = wave * 4 + rr; float v[8];
            { const f32x4 x0 = *(const LAS f32x4*)(CIN + t * 512 + lane * 8), x1 = *(const LAS f32x4*)(CIN + t * 512 + lane * 8 + 4); v[0] = x0[0]; v[1] = x0[1]; v[2] = x0[2]; v[3] = x0[3]; v[4] = x1[0]; v[5] = x1[1]; v[6] = x1[2]; v[7] = x1[3]; }
            float s = 0.f;
#pragma unroll
            for (int e = 0; e < 8; ++e) s += v[e];
            const float mu = wave_sum(s) * (1.0f / 512.0f); float q = 0.f;
#pragma unroll
            for (int e = 0; e < 8; ++e) { v[e] -= mu; q += v[e] * v[e]; }
            const float rstd = rsqrtf(wave_sum(q) * (1.0f / 512.0f) + EPS); float y[8];
#pragma unroll
            for (int e = 0; e < 8; ++e) y[e] = siluf(v[e] * rstd * g[e] + bt[e]);
            st8(MIX + (size_t)(b * SEQ + t0 + t) * DM + 1024 + lane * 8, y); } }
}
__device__ __forceinline__ void p2_conf_sample_w(CA a, int l, int s, int lane) {
    a = fresh_args();
    const bf16* Z = (const bf16*)(a->ws + WS_ZACT); bf16* MIX = (bf16*)(a->ws + WS_MIX);
    const int c8 = lane * 8; const size_t row = (size_t)(NPROMPT + s);
    float ga[8], gb[8], cin[8], acc[8], w[8];
    ld8(Z + row * NINP + ZC + c8, ga); ld8(Z + row * NINP + ZC + 512 + c8, gb);
    const float* cw = a->in[I_CCW] + (size_t)l * 31 * 512 + c8; ldf8(a->in[I_CCB] + l * 512 + c8, acc); ldf8(cw + 30 * 512, w);
#pragma unroll
    for (int e = 0; e < 8; ++e) { cin[e] = ga[e] * sigmf(gb[e]); acc[e] += w[e] * cin[e]; }
    const float* past = a->in[I_SCC] + ((size_t)(l * 128 + s) * 30) * 512 + c8; float* nc = a->out + O_CCS + ((size_t)(l * 128 + s) * 30) * 512 + c8;
#pragma unroll 1
    for (int jb = 0; jb < 30; jb += 6) { float pv[6][8], wv[6][8];
#pragma unroll
        for (int j = 0; j < 6; ++j) { ldf8(past + (jb + j) * 512, pv[j]); ldf8(cw + (jb + j) * 512, wv[j]); }
#pragma unroll
        for (int j = 0; j < 6; ++j) {
#pragma unroll
            for (int e = 0; e < 8; ++e) acc[e] += wv[j][e] * pv[j][e];
            if (jb + j >= 1) stf8(nc + (jb + j - 1) * 512, pv[j]); } }
    stf8(nc + 29 * 512, cin);
    float sm = 0.f;
#pragma unroll
    for (int e = 0; e < 8; ++e) sm += acc[e];
    const float mu = wave_sum(sm) * (1.0f / 512.0f); float q = 0.f;
#pragma unroll
    for (int e = 0; e < 8; ++e) { acc[e] -= mu; q += acc[e] * acc[e]; }
    const float rstd = rsqrtf(wave_sum(q) * (1.0f / 512.0f) + EPS); float g[8], bt[8], y[8];
    ldf8(a->in[I_LNCG] + l * 512 + c8, g); ldf8(a->in[I_LNCB] + l * 512 + c8, bt);
#pragma unroll
    for (int e = 0; e < 8; ++e) y[e] = siluf(acc[e] * rstd * g[e] + bt[e]);
    st8(MIX + row * DM + 1024 + c8, y);
}
__device__ __forceinline__ void p2_gla_sample_w(CA a, int l, int it, int lane) {
    a = fresh_args();
    const int s = it >> 2, h = it & 3; const size_t row = (size_t)(NPROMPT + s);
    const bf16* Z = (const bf16*)(a->ws + WS_ZACT); bf16* MIX = (bf16*)(a->ws + WS_MIX);
    float acc = a->in[I_ABIAS][l * 256 + h * 64 + lane];
    { float g[8], g2[8]; ld8(Z + row * NINP + ZLR, g); ld8(Z + row * NINP + ZLR + 8, g2);
#pragma unroll
        for (int r = 0; r < 8; ++r) acc += g[r] * a->in[I_A2][(l * 16 + r) * 256 + h * 64 + lane];
#pragma unroll
        for (int r = 0; r < 8; ++r) acc += g2[r] * a->in[I_A2][(l * 16 + 8 + r) * 256 + h * 64 + lane]; }
    const float av = __expf(logsigf(acc) * (1.0f / 16.0f)), qv = bf2f(Z[row * NINP + ZQ + h * 64 + lane]) * 0.125f, kv = bf2f(Z[row * NINP + ZK + h * 64 + lane]);
    const unsigned vw = *(const unsigned*)(Z + row * NINP + ZV + h * 128 + lane * 2); const float v0 = bflo(vw), v1 = bfhi(vw);
    const size_t so = ((size_t)((l * 128 + s) * 4 + h) * 64) * 128;
    const float* S0 = a->in[I_SGLA] + so + lane * 2; float* Sn = a->out + O_GS + so + lane * 2; float o0 = 0.f, o1 = 0.f;
#pragma unroll 1
    for (int db = 0; db < 64; db += 32) { f32x2 sv[32];
#pragma unroll
        for (int j = 0; j < 32; ++j) sv[j] = *(const f32x2*)(S0 + (db + j) * 128);
#pragma unroll
        for (int j = 0; j < 32; ++j) { const int d = db + j;
            const float ad = __int_as_float(__builtin_amdgcn_readlane(__float_as_int(av), d)), kd = __int_as_float(__builtin_amdgcn_readlane(__float_as_int(kv), d)), qd = __int_as_float(__builtin_amdgcn_readlane(__float_as_int(qv), d));
            f32x2 t; t.x = ad * sv[j].x + kd * v0; t.y = ad * sv[j].y + kd * v1; *(f32x2*)(Sn + d * 128) = t; o0 += qd * t.x; o1 += qd * t.y; } }
    const float rs = rsqrtf(wave_sum(o0 * o0 + o1 * o1) * (1.0f / 128.0f) + EPS);
    const float g0 = a->in[I_GNORM][l * 512 + h * 128 + lane * 2], g1 = a->in[I_GNORM][l * 512 + h * 128 + lane * 2 + 1];
    const unsigned grw = *(const unsigned*)(Z + row * NINP + ZR + h * 128 + lane * 2);
    *(unsigned*)(MIX + row * DM + 512 + h * 128 + lane * 2) = pk2(o0 * rs * g0 * siluf(bflo(grw)), o1 * rs * g1 * siluf(bfhi(grw)));
}
struct RowIn { u32x4 ax, ac, ab, ax1, ac1, ax2, ac2, vv, uu; };
__device__ __forceinline__ void p2_row_load(CA a, int l, int r, int lane, RowIn& R) {
    a = fresh_args();
    const bf16* zr = (const bf16*)(a->ws + WS_ZACT) + (size_t)r * NINP; const int c0 = lane * 8; const bool smp = r >= NPROMPT; const int t = r & 2047, s = r - NPROMPT;
    const u32x4 z4 = (u32x4){0u, 0u, 0u, 0u};
    R.ax = *(const u32x4*)(zr + ZAX + c0); R.ac = *(const u32x4*)(zr + ZAC + c0); R.ab = *(const u32x4*)(zr + ZAB + c0); R.vv = *(const u32x4*)(zr + ZD + 512 + c0);
    R.ax1 = z4; R.ac1 = z4; R.ax2 = z4; R.ac2 = z4; R.uu = z4;
    if (smp) { const float* st = a->in[I_SCA] + ((size_t)(l * 128 + s) * 2) * 512 + c0; R.ax2 = *(const u32x4*)st; R.ac2 = *(const u32x4*)(st + 4); R.ax1 = *(const u32x4*)(st + 512); R.ac1 = *(const u32x4*)(st + 516); R.uu = *(const u32x4*)(zr + ZD + c0); }
    else { if (t >= 1) { R.ax1 = *(const u32x4*)(zr - NINP + ZAX + c0); R.ac1 = *(const u32x4*)(zr - NINP + ZAC + c0); }
           if (t >= 2) { R.ax2 = *(const u32x4*)(zr - 2 * NINP + ZAX + c0); R.ac2 = *(const u32x4*)(zr - 2 * NINP + ZAC + c0); } }
}
__device__ __forceinline__ void p2_row_compute(CA a, int l, int r, int lane, const RowIn& R) {
    a = fresh_args();
    bf16* MIX = (bf16*)(a->ws + WS_MIX); bf16* VD = (bf16*)(a->ws + WS_VD);
    const int c0 = lane * 8; const bool smp = r >= NPROMPT; const int b = r >> 11, t = r & 2047, s = r - NPROMPT;
    float ax[8], ac[8], ab[8], p0[8], p1[8], p2[8], w0[8], w1[8], w2[8], y[8];
    up8(R.ax, ax); up8(R.ac, ac); up8(R.ab, ab);
#pragma unroll
    for (int e = 0; e < 8; ++e) p0[e] = ac[e] * ax[e];
    if (smp) { p1[0] = __uint_as_float(R.ax1.x); p1[1] = __uint_as_float(R.ax1.y); p1[2] = __uint_as_float(R.ax1.z); p1[3] = __uint_as_float(R.ax1.w); p1[4] = __uint_as_float(R.ac1.x); p1[5] = __uint_as_float(R.ac1.y); p1[6] = __uint_as_float(R.ac1.z); p1[7] = __uint_as_float(R.ac1.w);
               p2[0] = __uint_as_float(R.ax2.x); p2[1] = __uint_as_float(R.ax2.y); p2[2] = __uint_as_float(R.ax2.z); p2[3] = __uint_as_float(R.ax2.w); p2[4] = __uint_as_float(R.ac2.x); p2[5] = __uint_as_float(R.ac2.y); p2[6] = __uint_as_float(R.ac2.z); p2[7] = __uint_as_float(R.ac2.w); }
    else { up8(R.ax1, ax); up8(R.ac1, ac);
#pragma unroll
        for (int e = 0; e < 8; ++e) p1[e] = ac[e] * ax[e];
        up8(R.ax2, ax); up8(R.ac2, ac);
#pragma unroll
        for (int e = 0; e < 8; ++e) p2[e] = ac[e] * ax[e]; }
    ldf8(a->in[I_CAW] + (l * 3 + 0) * 512 + c0, w0); ldf8(a->in[I_CAW] + (l * 3 + 1) * 512 + c0, w1); ldf8(a->in[I_CAW] + (l * 3 + 2) * 512 + c0, w2);
#pragma unroll
    for (int e = 0; e < 8; ++e) y[e] = ab[e] * (w0[e] * p2[e] + w1[e] * p1[e] + w2[e] * p0[e]);
    st8(MIX + (size_t)r * DM + c0, y);
    if (smp) { stf8(a->out + O_CAS + ((size_t)(l * 128 + s) * 2 + 0) * 512 + c0, p1); stf8(a->out + O_CAS + ((size_t)(l * 128 + s) * 2 + 1) * 512 + c0, p0); }
    else if (t >= SEQ - 2) stf8(a->out + O_CAP + ((size_t)(l * 4 + b) * 2 + (t - (SEQ - 2))) * 512 + c0, p0);
    float v[8], g[8], bt[8]; up8(R.vv, v); float sm = 0.f;
#pragma unroll
    for (int e = 0; e < 8; ++e) { v[e] = geluf(v[e]); sm += v[e]; }
    const float mu = wave_sum(sm) * (1.0f / 512.0f); float q = 0.f;
#pragma unroll
    for (int e = 0; e < 8; ++e) { v[e] -= mu; q += v[e] * v[e]; }
    const float rstd = rsqrtf(wave_sum(q) * (1.0f / 512.0f) + EPS);
    ldf8(a->in[I_LNDG] + l * 512 + c0, g); ldf8(a->in[I_LNDB] + l * 512 + c0, bt);
#pragma unroll
    for (int e = 0; e < 8; ++e) v[e] = v[e] * rstd * g[e] + bt[e];
    if (smp) { stf8(a->out + O_SVS + (size_t)(l * 128 + s) * 512 + c0, v);
        const int h = c0 >> 7; const float w00 = a->in[I_SGW][(size_t)(l * 4 + h) * 128 * 128], b00 = a->in[I_SGB][(l * 4 + h) * 128]; float up[8];
        up8(R.uu, up);
#pragma unroll
        for (int e = 0; e < 8; ++e) y[e] = geluf(up[e]) * (w00 * v[e] + b00);
        st8(MIX + (size_t)r * DM + 1536 + c0, y); }
    else { st8(VD + (size_t)r * 512 + c0, v); if (t >= SEQ - 128) stf8(a->out + O_SVP + ((size_t)(l * 4 + b) * 128 + (t - (SEQ - 128))) * 512 + c0, v); }
}

#define XB_TMO      128
#define XB_XCNT(j)  (256  + 64 * (j))
#define XB_XSUB(j)  (1280 + 64 * (j))
#define XB_XGEN(j)  (2304 + 64 * (j))
#define XB_TOP      3328
#define XB_TOPGEN   3392
#define XCD_BAR_WORDS 3456
#define XB_SPIN_CAP (1u << 18)

__device__ __forceinline__ unsigned xb_ld(unsigned* p)              { return __hip_atomic_load(p, __ATOMIC_RELAXED, __HIP_MEMORY_SCOPE_AGENT); }
__device__ __forceinline__ unsigned xb_add(unsigned* p, unsigned v) { return __hip_atomic_fetch_add(p, v, __ATOMIC_RELAXED, __HIP_MEMORY_SCOPE_AGENT); }
__device__ __forceinline__ unsigned xb_xcc_id() { return (unsigned)__builtin_amdgcn_s_getreg((3 << 11) | 20) & 0xFu; }
#define XB_SPIN(cond, bar) do { unsigned _sp = 0; while (cond) { __builtin_amdgcn_s_sleep(1); \
    if ((++_sp & 255u) == 0u) { if (xb_ld(&(bar)[XB_TMO])) break; if (_sp > XB_SPIN_CAP) { atomicAdd(&(bar)[XB_TMO], 1u); break; } } } } while (0)

struct XcdBarrier {
    unsigned* bar; unsigned x;
    volatile LAS unsigned* st;
};

__device__ __forceinline__ XcdBarrier xcd_barrier_post(unsigned* bar, volatile LAS unsigned* st) {
    XcdBarrier b; b.bar = bar; b.x = xb_xcc_id(); b.st = st;
    if (threadIdx.x == 0) (void)xb_add(&bar[XB_XCNT(b.x)], 1u);
    return b;
}
__device__ __forceinline__ void xcd_barrier_complete(unsigned* bar, unsigned x, unsigned& nloc, unsigned& nx) {
    const unsigned G = gridDim.x * gridDim.y * gridDim.z;
    unsigned sum, cnt, mine, sp = 0u;
    for (;;) {
        sum = 0u; cnt = 0u; mine = 0u;
#pragma unroll
        for (unsigned j = 0; j < 16; ++j) { const unsigned c = xb_ld(&bar[XB_XCNT(j)]); sum += c; cnt += (c > 0u) ? 1u : 0u; mine = (j == x) ? c : mine; }
        if (sum == G) break;
        __builtin_amdgcn_s_sleep(1);
        if ((++sp & 255u) == 0u) { if (xb_ld(&bar[XB_TMO])) break; if (sp > XB_SPIN_CAP) { atomicAdd(&bar[XB_TMO], 1u); break; } }
    }
    nloc = mine > 0u ? mine : 1u; nx = cnt > 0u ? cnt : 1u;
}

__device__ __forceinline__ void xcd_barrier(const XcdBarrier& b) {
    asm volatile("s_waitcnt vmcnt(0)" ::: "memory");
    __syncthreads();
    if (threadIdx.x == 0) {
        unsigned* bar = b.bar;
        __builtin_amdgcn_s_waitcnt(0);
        unsigned nloc = b.st[0], nx = b.st[1];
        if (nloc == 0u) { xcd_barrier_complete(bar, b.x, nloc, nx); b.st[0] = nloc; b.st[1] = nx; }
        const unsigned old = xb_add(&bar[XB_XSUB(b.x)], 1u);
        const unsigned gen = old / nloc;
        if (old + 1u == (gen + 1u) * nloc) {
            __builtin_amdgcn_fence(__ATOMIC_RELEASE, "agent");
            asm volatile("s_waitcnt vmcnt(0)" ::: "memory");
            const unsigned og = xb_add(&bar[XB_TOP], 1u);
            const unsigned tg = og / nx;
            if (og + 1u == (tg + 1u) * nx) xb_add(&bar[XB_TOPGEN], 1u);
            else XB_SPIN(xb_ld(&bar[XB_TOPGEN]) == tg, bar);
            __builtin_amdgcn_fence(__ATOMIC_ACQUIRE, "agent");
            xb_add(&bar[XB_XGEN(b.x)], 1u);
            asm volatile("s_waitcnt vmcnt(0)" ::: "memory");
        } else {
            XB_SPIN(xb_ld(&bar[XB_XGEN(b.x)]) == gen, bar);
            __builtin_amdgcn_fence(__ATOMIC_ACQUIRE, "agent");
            asm volatile("s_waitcnt vmcnt(0)" ::: "memory");
        }
    }
    __syncthreads();
}

#ifndef REP_P1
#define REP_P1 1
#endif
#ifndef REP_P6
#define REP_P6 1
#endif
#ifndef REP_GDS
#define REP_GDS 1
#endif
#ifndef REP_CONF
#define REP_CONF 1
#endif
#ifndef REP_WI
#define REP_WI 1
#endif
#ifndef REP_P0
#define REP_P0 1
#endif
#ifndef REP_P2
#define REP_P2 1
#endif
#ifndef REP_P4
#define REP_P4 1
#endif
#define FRESH() int tid = threadIdx.x; asm volatile("" : "+v"(tid)); const int lane = tid & 63, wave = __builtin_amdgcn_readfirstlane(tid >> 6), blk = blockIdx.x, nblk = gridDim.x; CA a = fresh_args(); unsigned char* ws = a->ws; (void)lane; (void)wave; (void)blk; (void)nblk; (void)ws
__global__ void __launch_bounds__(512, 2) mk_fwd(Args kargs) {
    extern __shared__ __attribute__((aligned(16))) unsigned char lds_raw[];
    LAS unsigned char* lds = (LAS unsigned char*)lds_raw;
    cg::grid_group grid = cg::this_grid();
    volatile LAS unsigned* bst = (volatile LAS unsigned*)(lds + LDS_BYTES - 64);
    { FRESH(); if (tid < 16) bst[tid] = 0u; __syncthreads();
      if (a->pad0 == 0x5eed5eed) grid.sync();
      (void)xcd_barrier_post((unsigned*)(ws + WS_BAR), bst); }
#define SEAM() do { CA a_ = fresh_args(); XcdBarrier xb_; xb_.bar = (unsigned*)(a_->ws + WS_BAR); xb_.x = xb_xcc_id(); xb_.st = bst; xcd_barrier(xb_); } while (0)
#pragma unroll 1
    for (int l = 0; l < 2; ++l) {
#ifndef NO_P0
        for (int rep = 0; rep < REP_P0; ++rep) { FRESH(); p0_prologue(a, l, lds, blk * 8 + wave, nblk * 8, wave, lane); }
#endif
        SEAM();
#ifndef NO_P1
        {
            FRESH(); unsigned char* wl = ws + WS_W;
            pg8::Gemm g{(const bf16*)(ws + WS_XB), (const bf16*)(wl + WL_IN), MP, NINP, DM}; pg8::StaticOrder S; S.init(MP, NINP, nblk, blk, DM);
            pg8::EpiZ E{(bf16*)(ws + WS_ZACT), NINP, (const float*)(ws + WS_SSQ) + (2 * l) * MP};
            for (int rep = 0; rep < REP_P1; ++rep) pg8::gemm_phase<pg8::EpiZ, pg8::StaticOrder, true, true>(lds, g, S, E);
        }
#endif
        SEAM();
#ifndef NO_P2
        {
            FRESH();
            for (int it = blk; it < 768; it += nblk) {
                if (it < 512) { for (int rep = 0; rep < REP_GDS; ++rep) p2_gla_ds(a, l, it, lds, tid); }
                else { for (int rep = 0; rep < REP_CONF; ++rep) p2_conf(a, l, it - 512, lds, tid, wave, lane); }
            }
            if (nblk == 256) {
                const int gwv = blk * 8 + wave, g16 = gwv >> 4, w16 = gwv & 15;
                if (w16 < 5) { const int si = g16 * 5 + w16; if (si < 512) p2_gla_sample_w(a, l, si, lane); else p2_conf_sample_w(a, l, si - 512, lane);
                    const int r0 = 7040 + si * 2; RowIn R0, R1; p2_row_load(a, l, r0, lane, R0); p2_row_load(a, l, r0 + 1, lane, R1); p2_row_compute(a, l, r0, lane, R0); p2_row_compute(a, l, r0 + 1, lane, R1); }
                else { const int r0 = (g16 * 11 + (w16 - 5)) * 5;
#pragma unroll 1
                    for (int q = 0; q < 2; ++q) { RowIn R0, R1; p2_row_load(a, l, r0 + 2 * q, lane, R0); p2_row_load(a, l, r0 + 2 * q + 1, lane, R1); p2_row_compute(a, l, r0 + 2 * q, lane, R0); p2_row_compute(a, l, r0 + 2 * q + 1, lane, R1); }
                    { RowIn R0; p2_row_load(a, l, r0 + 4, lane, R0); p2_row_compute(a, l, r0 + 4, lane, R0); } }
            } else {
                for (int wi = blk * 8 + wave; wi < 4160 + 512 + 128; wi += nblk * 8) {
                    if (wi < 4160) { const int r0 = wi * 2; RowIn R0, R1; p2_row_load(a, l, r0, lane, R0); p2_row_load(a, l, r0 + 1, lane, R1); p2_row_compute(a, l, r0, lane, R0); p2_row_compute(a, l, r0 + 1, lane, R1); }
                    else if (wi < 4672) p2_gla_sample_w(a, l, wi - 4160, lane);
                    else p2_conf_sample_w(a, l, wi - 4672, lane);
                }
            }
        }
#endif
        SEAM();
        {
            FRESH();
            for (int gidx = blk * 512 + tid; gidx < 131072; gidx += nblk * 512) {
                const int bh = gidx >> 13, b = bh >> 2, h = bh & 3, e = gidx & 8191, d = e >> 7;
                float* DS = (float*)(ws + WS_DS); const float* dec = (const float*)(ws + WS_DEC); float Sv = 0.f;
                { float dsv[32], dcv[32];
#pragma unroll
                    for (int c = 0; c < 32; ++c) { const int itc = (b * 32 + c) * 4 + h; dsv[c] = DS[(size_t)itc * 8192 + e]; dcv[c] = dec[itc * 64 + d]; }
#pragma unroll
                    for (int c = 0; c < 32; ++c) { const int itc = (b * 32 + c) * 4 + h; DS[(size_t)itc * 8192 + e] = Sv; Sv = dcv[c] * Sv + dsv[c]; } }
                a->out[O_GP + (size_t)((l * 4 + b) * 4 + h) * 8192 + e] = Sv;
            }
        }
        SEAM();
#ifndef NO_P4
        {
            FRESH();
            for (int rep = 0; rep < REP_P4; ++rep)
            for (int it = blk; it < 768; it += nblk) { if (it < 512) p4_gla_o(a, l, it, lds, tid); else p4_sgu(a, l, it - 512, lds, tid); }
        }
#endif
        SEAM();
#ifndef NO_P5
        {
            FRESH(); unsigned char* wl = ws + WS_W;
            pg8::Gemm g{(const bf16*)(ws + WS_MIX), (const bf16*)(wl + WL_O), MP, DM, DM}; pg8::SplitOrder S; S.init(DM, nblk, blk, DM, 8);
            pg8::EpiRes<8> E{a->out + O_Y, (bf16*)(ws + WS_XB), (float*)(ws + WS_SSQ) + (2 * l + 1) * MP, (unsigned*)(ws + WS_CNT) + (2 * l) * 64, 8, (float*)(ws + WS_PART)};
            pg8::gemm_phase<pg8::EpiRes<8>, pg8::SplitOrder, true, true>(lds, g, S, E);
        }
#endif
        SEAM();
#ifndef NO_P6
        {
            FRESH(); unsigned char* wl = ws + WS_W;
            pg8::Gemm g{(const bf16*)(ws + WS_XB), (const bf16*)(wl + WL_GU), MP, 2 * DFF, DM}; pg8::StaticOrder S; S.init(MP, 2 * DFF, nblk, blk, DM);
            pg8::EpiGU E{(bf16*)(ws + WS_ZACT), DFF, (const float*)(ws + WS_SSQ) + (2 * l + 1) * MP};
            for (int rep = 0; rep < REP_P6; ++rep) pg8::gemm_phase<pg8::EpiGU, pg8::StaticOrder, true, true>(lds, g, S, E);
        }
#endif
        SEAM();
#ifndef NO_P7
        {
            FRESH(); unsigned char* wl = ws + WS_W;
            pg8::Gemm g{(const bf16*)(ws + WS_ZACT), (const bf16*)(wl + (l ? WL_D1 : WL_D)), MP, DM, DFF}; pg8::SplitOrder S; S.init(DM, nblk, blk, DFF, 11);
            pg8::EpiRes<11> E{a->out + O_Y, (bf16*)(ws + WS_XB), (float*)(ws + WS_SSQ) + (2 * l + 2) * MP, (unsigned*)(ws + WS_CNT) + (2 * l + 1) * 64, 11, (float*)(ws + WS_PART)};
            pg8::gemm_phase<pg8::EpiRes<11>, pg8::SplitOrder, true, true>(lds, g, S, E);
        }
#endif
        if (l == 1) SEAM();
    }
#ifdef EXTRA_SYNCS
    for (int q = 0; q < EXTRA_SYNCS; ++q) SEAM();
#endif
    {
        FRESH(); float* Y = a->out + O_Y; const bf16* XB = (const bf16*)(ws + WS_XB);
        for (int r0 = (blk * 8 + wave) * 2; r0 < MR; r0 += nblk * 16) {
            f32x4 v[2][8];
#pragma unroll
            for (int q = 0; q < 2; ++q) { const int r = r0 + q;
                if (r < NPROMPT) {
#pragma unroll
                    for (int j = 0; j < 8; ++j) { float t[4]; ld4(XB + (size_t)r * DM + 256 * j + 4 * lane, t); v[q][j] = (f32x4){t[0], t[1], t[2], t[3]}; }
                } else {
#pragma unroll
                    for (int j = 0; j < 8; ++j) v[q][j] = *(const f32x4*)(Y + (size_t)r * DM + 256 * j + 4 * lane);
                } }
            f32x4 gn[8];
#pragma unroll
            for (int j = 0; j < 8; ++j) gn[j] = *(const f32x4*)(a->in[I_NFIN] + 256 * j + 4 * lane);
#pragma unroll
            for (int q = 0; q < 2; ++q) { const int r = r0 + q; float ss = 0.f;
#pragma unroll
                for (int j = 0; j < 8; ++j) ss += (v[q][j][0] * v[q][j][0] + v[q][j][1] * v[q][j][1]) + (v[q][j][2] * v[q][j][2] + v[q][j][3] * v[q][j][3]);
                const float rs = rsqrtf(wave_sum(ss) * (1.0f / 2048.0f) + EPS);
#pragma unroll
                for (int j = 0; j < 8; ++j) *(f32x4*)(Y + (size_t)r * DM + 256 * j + 4 * lane) = v[q][j] * rs * gn[j]; }
        }
    }
}

extern "C" void kernel_launch(void* const* d_in, const int* in_sizes, int n_in, void* d_out, int out_size, void* d_ws, size_t ws_size, hipStream_t stream) {
    static int grid = 0;
    if (grid == 0) {
        int dev = 0, cus = 0, per_cu = 0;
        if (n_in != 25 || out_size != 30670848 || ws_size < WS_END) { fprintf(stderr, "kernel_launch: unexpected shapes (n_in %d out %d ws %zu, need %zu)\n", n_in, out_size, ws_size, (size_t)WS_END); grid = -1; return; }
        (void)hipGetDevice(&dev);
        (void)hipDeviceGetAttribute(&cus, hipDeviceAttributeMultiprocessorCount, dev);
        (void)hipFuncSetAttribute((const void*)mk_fwd, hipFuncAttributeMaxDynamicSharedMemorySize, LDS_BYTES);
        (void)hipOccupancyMaxActiveBlocksPerMultiprocessor(&per_cu, (const void*)mk_fwd, 512, LDS_BYTES);
        if (per_cu < 1) { fprintf(stderr, "kernel_launch: occupancy query reports %d blocks per CU\n", per_cu); grid = -1; return; }
        grid = cus;
    }
    if (grid < 0) return;
    (void)hipMemsetAsync((unsigned char*)d_ws + WS_BAR, 0, 256 * 1024, stream);
    Args ha{};
    for (int i = 0; i < 25; ++i) ha.in[i] = (const float*)d_in[i];
    ha.out = (float*)d_out; ha.ws = (unsigned char*)d_ws; ha.pad0 = 0; ha.pad1 = 0;
    void* args[] = {&ha};
    hipError_t e = hipLaunchCooperativeKernel((void*)mk_fwd, dim3(grid), dim3(512), args, LDS_BYTES, stream);
    if (e != hipSuccess) fprintf(stderr, "cooperative launch failed: %s (grid %d)\n", hipGetErrorString(e), grid);
}
```
